# Optimizing an MI355X kernel written in HIP

```python
import jax, jax.numpy as jnp
from jax import lax
import numpy as np

D_MODEL = 1024
BATCH = 4
SEQ = 8192
DEPTH = 4

CHUNK = 64
PE_DIM = 256
EPS = 1e-6
M_HEADS = 4
M_DK = 256
M_DV = 256
M_QK = M_HEADS * M_DK
M_V = M_HEADS * M_DV
CONV_K = 4
R_HEADS = 4
R_DK = 256
R_DV = 512
R_QK = R_HEADS * R_DK
R_V = R_HEADS * R_DV
ROPE_BASE = 10000.0
D_FF = 4 * D_MODEL
IN_SIZES = (M_QK, M_QK, M_V, M_V, M_HEADS, M_HEADS, R_QK, R_QK, R_V, R_V, D_MODEL, D_MODEL)
N_IN = M_QK * 2 + M_V * 2 + M_HEADS * 2 + R_QK * 2 + R_V * 2 + D_MODEL * 2
F_GATE_OFFSET = M_QK * 2 + M_V * 2 + M_HEADS

kernel_name = "hybrid_mlstm_retention_griffin_block"


def split_cols(z):
    outs = []
    off = 0
    for s in IN_SIZES:
        outs.append(z[..., off:off + s])
        off += s
    return outs


def rmsnorm(x, g):
    xf = x.astype(jnp.float32)
    y = xf * lax.rsqrt(jnp.mean(xf * xf, axis=-1, keepdims=True) + EPS)
    return (y * g.astype(jnp.float32)).astype(x.dtype)


def head_layernorm(y, g, n_heads):
    B, S, W = y.shape
    yf = y.astype(jnp.float32).reshape(B, S, n_heads, W // n_heads)
    mu = jnp.mean(yf, axis=-1, keepdims=True)
    var = jnp.mean(jnp.square(yf - mu), axis=-1, keepdims=True)
    yn = ((yf - mu) * lax.rsqrt(var + EPS)).reshape(B, S, W)
    return yn * g.astype(jnp.float32)


def causal_conv(u, w, b):
    S = u.shape[1]
    up = jnp.pad(u, ((0, 0), (CONV_K - 1, 0), (0, 0)))
    out = b
    for j in range(CONV_K):
        out = out + up[:, j:j + S, :] * w[j]
    return out


def rope(x, cos, sin):
    half = x.shape[-1] // 2
    x1, x2 = x[..., :half], x[..., half:]
    return jnp.concatenate([x1 * cos - x2 * sin, x1 * sin + x2 * cos], axis=-1)


def to_chunks(x, n_heads):
    B, S, W = x.shape
    return x.reshape(B, S // CHUNK, CHUNK, n_heads, W // n_heads).transpose(1, 0, 3, 2, 4)


def gates_to_chunks(g):
    B, S, H = g.shape
    return g.reshape(B, S // CHUNK, CHUNK, H).transpose(1, 0, 3, 2)


def from_chunks(y):
    NC, B, H, L, d = y.shape
    return y.transpose(1, 0, 3, 2, 4).reshape(B, NC * L, H * d)


def mlstm_chunkwise(q, k, v, li, lf):
    NC, B, H, L, dk = q.shape
    dv = v.shape[-1]
    causal = jnp.tril(jnp.ones((L, L), dtype=bool))

    def step(carry, inp):
        C, n, m = carry
        qc, kc, vc, lic, lfc = inp
        b = jnp.cumsum(lfc, axis=-1)
        log_intra = b[..., :, None] - b[..., None, :] + lic[..., None, :]
        log_intra = jnp.where(causal, log_intra, -jnp.inf)
        log_inter = b + m[..., None]
        m_t = jnp.maximum(log_inter, jnp.max(log_intra, axis=-1))
        d_intra = jnp.exp(log_intra - m_t[..., None])
        d_inter = jnp.exp(log_inter - m_t)
        s = jnp.einsum('bhtd,bhsd->bhts', qc, kc) * d_intra
        num = jnp.einsum('bhts,bhsv->bhtv', s, vc) + d_inter[..., None] * jnp.einsum('bhtd,bhdv->bhtv', qc, C)
        den = jnp.sum(s, axis=-1) + d_inter * jnp.einsum('bhtd,bhd->bht', qc, n)
        h = num / jnp.maximum(jnp.abs(den), jnp.exp(-m_t))[..., None]
        b_end = b[..., -1]
        log_w = b_end[..., None] - b + lic
        m_new = jnp.maximum(b_end + m, jnp.max(log_w, axis=-1))
        w = jnp.exp(log_w - m_new[..., None])
        decay = jnp.exp(b_end + m - m_new)
        C = decay[..., None, None] * C + jnp.einsum('bhsd,bhsv->bhdv', kc * w[..., None], vc)
        n = decay[..., None] * n + jnp.einsum('bhs,bhsd->bhd', w, kc)
        return (C, n, m_new), h

    init = (jnp.zeros((B, H, dk, dv), jnp.float32), jnp.zeros((B, H, dk), jnp.float32),
            jnp.zeros((B, H), jnp.float32))
    _, hs = lax.scan(step, init, (q, k, v, li, lf))
    return hs


def retention_chunkwise(q, k, v, log_gamma):
    NC, B, H, L, dk = q.shape
    dv = v.shape[-1]
    pos = jnp.arange(L, dtype=jnp.float32)
    diff = pos[:, None] - pos[None, :]
    lg = log_gamma[:, None, None]
    intra = jnp.where(diff >= 0, jnp.exp(jnp.maximum(diff, 0.0) * lg), 0.0)
    inter = jnp.exp((pos + 1.0) * log_gamma[:, None])
    kdec = jnp.exp((L - 1.0 - pos) * log_gamma[:, None])
    cdec = jnp.exp(L * log_gamma)

    def step(R, inp):
        qc, kc, vc = inp
        s = jnp.einsum('bhtd,bhsd->bhts', qc, kc) * intra
        y = jnp.einsum('bhts,bhsv->bhtv', s, vc) + jnp.einsum('bhtd,bhdv->bhtv', qc, R) * inter[..., None]
        R = cdec[:, None, None] * R + jnp.einsum('bhsd,bhsv->bhdv', kc * kdec[..., None], vc)
        return R, y

    _, ys = lax.scan(step, jnp.zeros((B, H, dk, dv), jnp.float32), (q, k, v))
    return ys


def setup_inputs(seed: int = 0) -> dict:
    key = jax.random.key(seed)
    ks = jax.random.split(key, 24)
    f32 = jnp.float32

    def nrm(k, shape, scale):
        return jax.random.normal(k, shape, f32) * scale

    def gain(k, shape):
        return 1.0 + 0.05 * jax.random.normal(k, shape, f32)

    b_in = nrm(ks[4], (DEPTH, N_IN), 0.02)
    f_bias = jnp.linspace(3.0, 6.0, M_HEADS, dtype=f32)[None, :] + nrm(ks[5], (DEPTH, M_HEADS), 0.1)
    b_in = b_in.at[:, F_GATE_OFFSET:F_GATE_OFFSET + M_HEADS].set(f_bias)
    return {
        "x": nrm(ks[0], (BATCH, SEQ, D_MODEL), 1.0),
        "p": nrm(ks[1], (DEPTH, BATCH, SEQ, PE_DIM), 1.0),
        "norm1_g": gain(ks[2], (DEPTH, D_MODEL)),
        "w_in": nrm(ks[3], (DEPTH, D_MODEL, N_IN), D_MODEL ** -0.5),
        "b_in": b_in,
        "conv_w": nrm(ks[6], (DEPTH, CONV_K, 2 * M_QK), CONV_K ** -0.5),
        "conv_b": nrm(ks[7], (DEPTH, 2 * M_QK), 0.02),
        "m_norm_g": gain(ks[8], (DEPTH, M_V)),
        "r_norm_g": gain(ks[9], (DEPTH, R_V)),
        "w_bm": nrm(ks[10], (DEPTH, M_V, D_MODEL), M_V ** -0.5),
        "w_br": nrm(ks[11], (DEPTH, R_V, D_MODEL), R_V ** -0.5),
        "w_out": nrm(ks[12], (DEPTH, D_MODEL, D_MODEL), D_MODEL ** -0.5),
        "norm2_g": gain(ks[13], (DEPTH, D_MODEL)),
        "w_ff1": nrm(ks[14], (DEPTH, D_MODEL, D_FF), D_MODEL ** -0.5),
        "b_ff1": nrm(ks[15], (DEPTH, D_FF), 0.02),
        "w_ff2": nrm(ks[16], (DEPTH, D_FF, D_MODEL), D_FF ** -0.5),
        "b_ff2": nrm(ks[17], (DEPTH, D_MODEL), 0.02),
        "norm3_g": gain(ks[18], (DEPTH, D_MODEL)),
        "w_pe_gate": nrm(ks[19], (DEPTH, D_MODEL, D_MODEL), D_MODEL ** -0.5),
        "w_pe": nrm(ks[20], (DEPTH, PE_DIM, D_MODEL), PE_DIM ** -0.5),
        "final_g": gain(ks[21], (D_MODEL,)),
    }


def reference(x, p, norm1_g, w_in, b_in, conv_w, conv_b, m_norm_g, r_norm_g, w_bm, w_br,
              w_out, norm2_g, w_ff1, b_ff1, w_ff2, b_ff2, norm3_g, w_pe_gate, w_pe, final_g):
    B, S, _ = x.shape
    dt = x.dtype
    f32 = jnp.float32
    pos = jnp.arange(S, dtype=f32)
    inv_freq = ROPE_BASE ** (-jnp.arange(0, R_DK, 2, dtype=f32) / R_DK)
    ang = pos[:, None] * inv_freq[None, :]
    cos = jnp.cos(ang)[:, None, :]
    sin = jnp.sin(ang)[:, None, :]
    log_gamma = jnp.log(1.0 - jnp.exp2(-5.0 - jnp.arange(R_HEADS, dtype=f32)))

    for i in range(DEPTH):
        h = rmsnorm(x, norm1_g[i])
        z = h @ w_in[i] + b_in[i]
        _, _, mv, mo, mi, mf, rq, rk, rv, rg, gm, gr = split_cols(z)
        qk = jax.nn.silu(causal_conv(z[..., :2 * M_QK], conv_w[i], conv_b[i]))
        mq = qk[..., :M_QK] * (M_DK ** -0.5)
        mk = qk[..., M_QK:]

        hm = mlstm_chunkwise(
            to_chunks(mq.astype(f32), M_HEADS), to_chunks(mk.astype(f32), M_HEADS),
            to_chunks(mv.astype(f32), M_HEADS),
            gates_to_chunks(mi.astype(f32)), gates_to_chunks(jax.nn.log_sigmoid(mf.astype(f32))))
        hm = from_chunks(hm)
        y_m = (jax.nn.sigmoid(mo.astype(f32)) * head_layernorm(hm, m_norm_g[i], M_HEADS)).astype(dt)

        rq4 = rope(rq.astype(f32).reshape(B, S, R_HEADS, R_DK), cos, sin)
        rk4 = rope(rk.astype(f32).reshape(B, S, R_HEADS, R_DK), cos, sin) * (R_DK ** -0.5)
        hr = retention_chunkwise(
            to_chunks(rq4.reshape(B, S, R_QK), R_HEADS), to_chunks(rk4.reshape(B, S, R_QK), R_HEADS),
            to_chunks(rv.astype(f32), R_HEADS), log_gamma)
        hr = from_chunks(hr)
        y_r = (jax.nn.silu(rg.astype(f32)) * head_layernorm(hr, r_norm_g[i], R_HEADS)).astype(dt)

        merged = jax.nn.sigmoid(gm) * (y_m @ w_bm[i]) + jax.nn.sigmoid(gr) * (y_r @ w_br[i])
        x = x + merged @ w_out[i]

        h2 = rmsnorm(x, norm2_g[i])
        x = x + jnp.square(jax.nn.relu(h2 @ w_ff1[i] + b_ff1[i])) @ w_ff2[i] + b_ff2[i]

        h3 = rmsnorm(x, norm3_g[i])
        x = x + jax.nn.sigmoid(h3 @ w_pe_gate[i]) * (p[i] @ w_pe[i])

    return rmsnorm(x, final_g)
```

```cpp
#include <hip/hip_runtime.h>
#include <hip/hip_cooperative_groups.h>
#include <cstdio>
#include <cstdint>
namespace cg = cooperative_groups;

#define LAS __attribute__((address_space(3)))
typedef unsigned short bf16_t;
typedef short bf16x8 __attribute__((ext_vector_type(8)));
typedef short s16x4 __attribute__((ext_vector_type(4)));
typedef float f32x4 __attribute__((ext_vector_type(4)));
typedef float f32x2 __attribute__((ext_vector_type(2)));
typedef unsigned u32x4 __attribute__((ext_vector_type(4)));
typedef unsigned u32x2 __attribute__((ext_vector_type(2)));

constexpr int XL_OFF = 131072, XL_SZ = 1280;
constexpr int NTOK = 32768, DM = 1024, SEQ = 8192, NLAYER = 4, NIN = 12296, ZW = 7168, FF = 4096, PED = 256;
constexpr float EPS = 1e-6f;
constexpr size_t MiB = 1u << 20;
constexpr size_t WS_W1 = 0, WS_WY = 15 * MiB, WS_WGM = 21 * MiB, WS_WGR = 23 * MiB, WS_WBM = 25 * MiB, WS_WBR = 27 * MiB, WS_WOUT = 31 * MiB,
                 WS_WFF1 = 33 * MiB, WS_WFF2 = 41 * MiB, WS_WPG = 49 * MiB, WS_WPE = 51 * MiB, WS_PB = 52 * MiB, WS_XB0 = 68 * MiB, WS_XB1 = 132 * MiB,
                 WS_MG = 196 * MiB, WS_GATES = 260 * MiB, WS_SS0 = 261 * MiB, WS_SS1 = 263 * MiB, WS_HSTAT = 265 * MiB, WS_ROPE = 281 * MiB, WS_Z = 289 * MiB,
                 WS_GV = 737 * MiB, WS_CTL = 739 * MiB, WS_WY1 = 740 * MiB, WS_WGM1 = 746 * MiB, WS_WGR1 = 748 * MiB, WS_END = 750 * MiB;
constexpr int LDS_BYTES = 155648;

struct Params {
    const float *x, *p, *norm1_g, *w_in, *b_in, *conv_w, *conv_b, *m_norm_g, *r_norm_g, *w_bm, *w_br, *w_out, *norm2_g, *w_ff1, *b_ff1, *w_ff2, *b_ff2,
        *norm3_g, *w_pe_gate, *w_pe, *final_g;
    float* out; unsigned char* ws;
};

__device__ __forceinline__ int lane_id_fresh() { unsigned z = 0u; asm volatile("" : "+v"(z)); return (int)__builtin_amdgcn_mbcnt_hi(~0u, __builtin_amdgcn_mbcnt_lo(~0u, z)); }
__device__ __forceinline__ unsigned cvt_pk_bf16(float lo, float hi) { unsigned r; asm volatile("v_cvt_pk_bf16_f32 %0, %1, %2" : "=v"(r) : "v"(lo), "v"(hi)); return r; }
__device__ __forceinline__ float bflo(unsigned u) { return __uint_as_float(u << 16); }
__device__ __forceinline__ float bfhi(unsigned u) { return __uint_as_float(u & 0xffff0000u); }
__device__ __forceinline__ float sigmoidf_(float v) { return 1.f / (1.f + __expf(-v)); }
__device__ __forceinline__ f32x4 sigmoid4(f32x4 v) { return (f32x4){sigmoidf_(v[0]), sigmoidf_(v[1]), sigmoidf_(v[2]), sigmoidf_(v[3])}; }
__device__ __forceinline__ u32x2 pack4(f32x4 v) { u32x2 w; w.x = cvt_pk_bf16(v[0], v[1]); w.y = cvt_pk_bf16(v[2], v[3]); return w; }
__device__ __forceinline__ u32x4 pack8(f32x4 a, f32x4 b) { u32x4 w; w.x = cvt_pk_bf16(a[0], a[1]); w.y = cvt_pk_bf16(a[2], a[3]); w.z = cvt_pk_bf16(b[0], b[1]); w.w = cvt_pk_bf16(b[2], b[3]); return w; }
#define LDS_WAIT() asm volatile("s_waitcnt lgkmcnt(0)" ::: "memory")

constexpr int BM = 256, BK = 64, HALF = 128, HTB = HALF * BK * 2, STAGE_BYTES = 8 * HTB, NXCD = 8, WGM = 8;
__device__ __forceinline__ int lds_byte(int r, int c) { const int st = (r >> 4) * 2 + (c >> 5), rr = r & 15, cc = c & 31, ob = rr * 64 + cc * 2; return st * 1024 + (ob ^ (((ob >> 9) & 1) << 5)); }
__device__ __forceinline__ int perm32(int rho) { const int n = rho >> 4, i = rho & 15; return 8 * (i >> 2) + 4 * n + (i & 3); }
__device__ __forceinline__ void stage_rc(int b, int& R, int& C) { const int st = b / 1024, sb = b % 1024, swz = sb ^ (((sb >> 9) & 1) << 5); R = (st >> 1) * 16 + swz / 64; C = (st & 1) * 32 + (swz % 64) / 2; }

struct UnitD { const char* A; const char* B; unsigned lda, ldb; int nt, pm, pn, sub; };
struct SubG { const char* A; const char* B; unsigned lda, ldb; int nt; };
struct TileOrder {
    int nM, nN, nwg, G, c;
    __device__ void init(int M, int N, int G_, int c_) { nM = M / BM; nN = N / BM; nwg = nM * nN; G = G_; c = c_; }
    __device__ bool tile(int i, int& pm, int& pn) const {
        const long L = (long)i * G + c; if (L >= nwg) return false;
        int wgid = (int)L; { const int q = nwg / NXCD, r = nwg % NXCD, xcd = wgid % NXCD, off = wgid / NXCD; wgid = (xcd < r ? xcd * (q + 1) : r * (q + 1) + (xcd - r) * q) + off; }
        const int nig = WGM * nN, gid = wgid / nig, fm = gid * WGM, gsz = (nM - fm) < WGM ? (nM - fm) : WGM;
        pm = fm + ((wgid % nig) % gsz); pn = (wgid % nig) / gsz; return true;
    }
};
template <int NSUB> struct Sched {
    TileOrder T; SubG g0, g1, g2, g3;
    __device__ __forceinline__ bool next(int ui, UnitD& u) const {
        const int round = ui / NSUB, sub = ui % NSUB; int pm, pn;
        if (!T.tile(round, pm, pn)) return false;
        const char* gA = g0.A; const char* gB = g0.B; unsigned glda = g0.lda, gldb = g0.ldb; int gnt = g0.nt;
        if (NSUB > 1) { const bool s1 = sub == 1; gA = s1 ? g1.A : gA; gB = s1 ? g1.B : gB; glda = s1 ? g1.lda : glda; gldb = s1 ? g1.ldb : gldb; gnt = s1 ? g1.nt : gnt; }
        if (NSUB > 2) { const bool s2 = sub == 2; gA = s2 ? g2.A : gA; gB = s2 ? g2.B : gB; glda = s2 ? g2.lda : glda; gldb = s2 ? g2.ldb : gldb; gnt = s2 ? g2.nt : gnt; }
        if (NSUB > 3) { const bool s3 = sub == 3; gA = s3 ? g3.A : gA; gB = s3 ? g3.B : gB; glda = s3 ? g3.lda : glda; gldb = s3 ? g3.ldb : gldb; gnt = s3 ? g3.nt : gnt; }
        u.A = gA + (size_t)pm * BM * glda; u.B = gB + (size_t)pn * BM * gldb; u.lda = glda; u.ldb = gldb; u.nt = gnt; u.pm = pm; u.pn = pn; u.sub = sub; return true;
    }
};

template <class Epi, class SchedT>
__device__ __forceinline__ void gemm_phase(LAS unsigned char* lds, const SchedT& S, const Epi& E, const int tid) {
    const int wid = __builtin_amdgcn_readfirstlane(tid >> 6), lane = tid & 63, wr = wid >> 2, wc = wid & 3, fr = lane & 15, fq = lane >> 4;
    int sR0, sC0, sR1, sC1; stage_rc(tid * 16, sR0, sC0); stage_rc(tid * 16 + 8192, sR1, sC1);
    UnitD cur, nxt; int ui = 0;
    if (!S.next(0, cur)) return;
    LAS float* xl = (LAS float*)(lds + XL_OFF);
#define PRE_TID() (wid * 64 + lane_id_fresh())
    E.pre(cur, PRE_TID(), xl);
    const unsigned sRr[2] = {(unsigned)sR0, (unsigned)sR1}, sCc[2] = {(unsigned)sC0 * 2u, (unsigned)sC1 * 2u};
    const unsigned sRb[2] = {(unsigned)((sR0 & ~31) + perm32(sR0 & 31)), (unsigned)((sR1 & ~31) + perm32(sR1 & 31))};
    const size_t kstep = (size_t)(BK * 2);
    const unsigned ldsw = (unsigned)wid * 1024u;
    const int aoff = lds_byte(wr * 64 + fr, fq * 8), boff = lds_byte(wc * 32 + fr, fq * 8);
#define PG8_SA(b, h) (((b) * 2 + (h)) * HTB)
#define PG8_SB(b, h) ((4 + (b) * 2 + (h)) * HTB)
#define PG8_STAGE_(bufoff, gbase, ld, RR) do { _Pragma("unroll") for (int _i = 0; _i < 2; ++_i) \
        __builtin_amdgcn_global_load_lds((const unsigned*)((const char*)(gbase) + (RR[_i] * (ld) + sCc[_i])), (LAS unsigned*)(lds + (bufoff) + ldsw + _i * 8192), 16, 0, 0); } while (0)
#define PG8_STAGE(bufoff, gbase, ld) PG8_STAGE_(bufoff, gbase, ld, sRr)
#define PG8_STAGEB(bufoff, gbase, ld) PG8_STAGE_(bufoff, gbase, ld, sRb)
#define PG8_LDA(dst, b, h) do { _Pragma("unroll") for (int m = 0; m < 4; ++m) _Pragma("unroll") for (int k = 0; k < 2; ++k) dst[m][k] = *(const LAS bf16x8*)(lds + PG8_SA(b, h) + aoff + m * 2048 + k * 1024); } while (0)
#define PG8_LDB(dst, b, h) do { _Pragma("unroll") for (int n = 0; n < 2; ++n) _Pragma("unroll") for (int k = 0; k < 2; ++k) dst[n][k] = *(const LAS bf16x8*)(lds + PG8_SB(b, h) + boff + n * 2048 + k * 1024); } while (0)
#define PG8_MMA(ai, bj, At, Bt) do { __builtin_amdgcn_s_setprio(1); _Pragma("unroll") for (int m = 0; m < 4; ++m) _Pragma("unroll") for (int n = 0; n < 2; ++n) _Pragma("unroll") for (int k = 0; k < 2; ++k) \
        acc[ai][bj][m][n] = __builtin_amdgcn_mfma_f32_16x16x32_bf16(Bt[n][k], At[m][k], acc[ai][bj][m][n], 0, 0, 0); __builtin_amdgcn_s_setprio(0); } while (0)
#define PG8_WAIT_V(n) asm volatile("s_waitcnt vmcnt(" #n ")" ::: "memory")
#define PG8_WAIT_L(n) asm volatile("s_waitcnt lgkmcnt(" #n ")" ::: "memory")
#define PG8_WAIT_VX() PG8_WAIT_V(8)
#define PG8_BAR __builtin_amdgcn_s_barrier()
#define PG8_SCHED __builtin_amdgcn_sched_barrier(0)
    f32x4 acc[2][2][4][2];
#pragma unroll
    for (int a = 0; a < 2; ++a)
#pragma unroll
        for (int b = 0; b < 2; ++b)
#pragma unroll
            for (int m = 0; m < 4; ++m)
#pragma unroll
                for (int n = 0; n < 2; ++n) acc[a][b][m][n] = (f32x4){0.f, 0.f, 0.f, 0.f};
    bf16x8 At[4][2], B0[2][2], B1[2][2];
    const char* cA = cur.A; const char* cB = cur.B;
    {
        const size_t hA = (size_t)HALF * cur.lda, hB = (size_t)HALF * cur.ldb;
        PG8_STAGEB(PG8_SB(0, 0), cB, cur.ldb); PG8_STAGEB(PG8_SB(0, 1), cB + hB, cur.ldb); PG8_STAGE(PG8_SA(0, 0), cA, cur.lda); PG8_STAGE(PG8_SA(0, 1), cA + hA, cur.lda);
        if (wr == 1) PG8_BAR;
        PG8_WAIT_V(2); PG8_BAR;
        PG8_STAGEB(PG8_SB(1, 0), cB + kstep, cur.ldb); PG8_STAGE(PG8_SA(1, 0), cA + kstep, cur.lda); PG8_STAGEB(PG8_SB(1, 1), cB + hB + kstep, cur.ldb);
        PG8_WAIT_V(6); PG8_BAR;
    }
    for (;;) {
        const bool has_next = S.next(ui + 1, nxt);
        const char* nA = has_next ? nxt.A : cA; const char* nB = has_next ? nxt.B : cB;
        const unsigned nlda = has_next ? nxt.lda : cur.lda, nldb = has_next ? nxt.ldb : cur.ldb;
        const size_t hA = (size_t)HALF * cur.lda, hB = (size_t)HALF * cur.ldb, nhA = (size_t)HALF * nlda, nhB = (size_t)HALF * nldb;
        const int nt = cur.nt;
        for (int t = 0; t < nt; t += 2) {
            const bool last = (t == nt - 2);
            const char* a1 = cA + (size_t)(t + 1) * kstep;
            const char* a2 = last ? nA : cA + (size_t)(t + 2) * kstep; const char* b2 = last ? nB : cB + (size_t)(t + 2) * kstep;
            const char* a3 = a2 + kstep; const char* b3 = b2 + kstep;
            const unsigned la2 = last ? nlda : cur.lda, lb2 = last ? nldb : cur.ldb;
            const size_t ha2 = last ? nhA : hA, hb2 = last ? nhB : hB;
            PG8_LDB(B0, 0, 0); PG8_LDB(B1, 0, 1); PG8_SCHED; PG8_LDA(At, 0, 0); PG8_STAGE(PG8_SA(1, 1), a1 + hA, cur.lda);
            PG8_WAIT_VX(); PG8_WAIT_L(0); PG8_BAR; PG8_MMA(0, 0, At, B0); PG8_MMA(0, 1, At, B1); PG8_BAR; PG8_SCHED;
            PG8_LDA(At, 0, 1); PG8_STAGEB(PG8_SB(0, 0), b2, lb2); PG8_STAGEB(PG8_SB(0, 1), b2 + hb2, lb2); PG8_STAGE(PG8_SA(0, 0), a2, la2);
            PG8_WAIT_VX(); PG8_WAIT_L(0); PG8_BAR; PG8_MMA(1, 0, At, B0); PG8_MMA(1, 1, At, B1); PG8_BAR; PG8_SCHED;
            PG8_LDB(B0, 1, 0); PG8_LDB(B1, 1, 1); PG8_SCHED; PG8_LDA(At, 1, 0); PG8_STAGE(PG8_SA(0, 1), a2 + ha2, la2);
            PG8_WAIT_VX(); PG8_WAIT_L(0); PG8_BAR; PG8_MMA(0, 0, At, B0); PG8_MMA(0, 1, At, B1); PG8_BAR; PG8_SCHED;
            PG8_LDA(At, 1, 1); PG8_STAGEB(PG8_SB(1, 0), b3, lb2); PG8_STAGEB(PG8_SB(1, 1), b3 + hb2, lb2); PG8_STAGE(PG8_SA(1, 0), a3, la2);
            PG8_WAIT_V(8); PG8_WAIT_L(0); PG8_BAR; PG8_MMA(1, 0, At, B0); PG8_MMA(1, 1, At, B1); PG8_BAR; PG8_SCHED;
        }
        if (wr == 0) PG8_BAR;
        (void)E(acc, cur, wr, wc, fr, fq, xl + (ui & 1) * XL_SZ);
        if (has_next) E.pre(nxt, PRE_TID(), xl + ((ui + 1) & 1) * XL_SZ);
        if (!has_next) break;
#pragma unroll
        for (int a = 0; a < 2; ++a)
#pragma unroll
            for (int b = 0; b < 2; ++b)
#pragma unroll
                for (int m = 0; m < 4; ++m)
#pragma unroll
                    for (int n = 0; n < 2; ++n) acc[a][b][m][n] = (f32x4){0.f, 0.f, 0.f, 0.f};
        cur = nxt; cA = nA; cB = nB; ++ui;
        if (wr == 1) PG8_BAR;
    }
    PG8_WAIT_V(0);
    PG8_BAR;
#undef PG8_SA
#undef PG8_SB
#undef PG8_STAGE
#undef PG8_STAGEB
#undef PG8_STAGE_
#undef PG8_LDA
#undef PG8_LDB
#undef PG8_MMA
#undef PG8_WAIT_V
#undef PG8_WAIT_L
#undef PG8_WAIT_VX
#undef PG8_BAR
#undef PG8_SCHED
}

typedef f32x4 AccT[2][2][4][2];
#define ROW(ai, m) (u.pm * BM + (ai) * HALF + wr * 64 + (m) * 16 + fr)
#define COL(bj, n) (u.pn * BM + (bj) * HALF + wc * 32 + fq * 8 + (n) * 4)
#define FOR_AI _Pragma("unroll") for (int ai = 0; ai < 2; ++ai)
#define FOR_M _Pragma("unroll") for (int m = 0; m < 4; ++m)
#define FOR_BJ _Pragma("unroll") for (int bj = 0; bj < 2; ++bj)
#define FOR_N _Pragma("unroll") for (int n = 0; n < 2; ++n)
__device__ __forceinline__ void rows_rstd(const float* ss, const UnitD& u, int wr, int fr, int fq, float (&rs)[2][4]) {
    f32x4 v[2][4];
    FOR_AI FOR_M v[ai][m] = *(const f32x4*)(ss + (size_t)ROW(ai, m) * 16 + fq * 4);
    float t[2][4], e[2][4];
    FOR_AI FOR_M t[ai][m] = (v[ai][m][0] + v[ai][m][1]) + (v[ai][m][2] + v[ai][m][3]);
    FOR_AI FOR_M e[ai][m] = __shfl_xor(t[ai][m], 16);
    FOR_AI FOR_M t[ai][m] += e[ai][m];
    FOR_AI FOR_M e[ai][m] = __shfl_xor(t[ai][m], 32);
    FOR_AI FOR_M rs[ai][m] = rsqrtf((t[ai][m] + e[ai][m]) * (1.f / DM) + EPS);
}

__device__ __forceinline__ void pre_rstd(const float* ss, const UnitD& nu, int tid, LAS float* xb) {
    const float* sp = ss + (size_t)(nu.pm * BM + (tid >> 1)) * 16 + (tid & 1) * 8;
    const f32x4 t = *(const f32x4*)sp + *(const f32x4*)(sp + 4);
    float s = (t[0] + t[1]) + (t[2] + t[3]);
    s += __shfl_xor(s, 1);
    if ((tid & 1) == 0) xb[tid >> 1] = rsqrtf(s * (1.f / DM) + EPS);
}
__device__ __forceinline__ void pre_vec(const float* src, int tid, LAS float* dst) { if (tid < 64) *(LAS f32x4*)(dst + tid * 4) = *(const f32x4*)(src + tid * 4); }
#define XB_RS(ai, m) xb[(ai) * HALF + wr * 64 + (m) * 16 + fr]
#define XB_MU(ai, m) xb[256 + (ai) * HALF + wr * 64 + (m) * 16 + fr]
#define XB_HR(ai, m) xb[512 + (ai) * HALF + wr * 64 + (m) * 16 + fr]
#define XB_BI(bj, n) (*(const LAS f32x4*)(xb + 768 + (bj) * HALF + wc * 32 + fq * 8 + (n) * 4))
#define XB_GN(bj, n) (*(const LAS f32x4*)(xb + 1024 + (bj) * HALF + wc * 32 + fq * 8 + (n) * 4))

__device__ __forceinline__ void unpack8(const u32x4 w, f32x4& a, f32x4& b) { a = (f32x4){bflo(w.x), bfhi(w.x), bflo(w.y), bfhi(w.y)}; b = (f32x4){bflo(w.z), bfhi(w.z), bflo(w.w), bfhi(w.w)}; }
template <bool BIAS, bool GATED>
__device__ __forceinline__ int x_update(const AccT& acc, const UnitD& u, int wr, int wc, int fr, int fq, const bf16_t* xin, bf16_t* xout, float* ss, const float* bias, const bf16_t* gate) {
    f32x4 bv[2][2];
    FOR_BJ FOR_N bv[bj][n] = BIAS ? *(const f32x4*)(bias + COL(bj, n)) : (f32x4){0.f, 0.f, 0.f, 0.f};
    FOR_AI {
#pragma unroll
      for (int mh = 0; mh < 2; ++mh) {
        u32x4 xv[4][2], gv[4][2];
#pragma unroll
        for (int m = mh * 2; m < mh * 2 + 2; ++m) FOR_BJ {
            const size_t o = (size_t)ROW(ai, m) * DM + COL(bj, 0);
            xv[m][bj] = *(const u32x4*)(xin + o);
            if (GATED) gv[m][bj] = *(const u32x4*)(gate + o);
        }
#pragma unroll
        for (int m = mh * 2; m < mh * 2 + 2; ++m) {
            const int row = ROW(ai, m);
            float part = 0.f;
            FOR_BJ {
                f32x4 x0, x1; unpack8(xv[m][bj], x0, x1);
                f32x4 a0 = acc[ai][bj][m][0], a1 = acc[ai][bj][m][1];
                if (GATED) { f32x4 g0, g1; unpack8(gv[m][bj], g0, g1); a0 = a0 * g0; a1 = a1 * g1; }
                if (BIAS) { a0 = a0 + bv[bj][0]; a1 = a1 + bv[bj][1]; }
                const f32x4 r0 = x0 + a0, r1 = x1 + a1;
                part += ((r0[0] * r0[0] + r0[1] * r0[1]) + (r0[2] * r0[2] + r0[3] * r0[3])) + ((r1[0] * r1[0] + r1[1] * r1[1]) + (r1[2] * r1[2] + r1[3] * r1[3]));
                *(u32x4*)(xout + (size_t)row * DM + COL(bj, 0)) = pack8(r0, r1);
            }
            part += __shfl_xor(part, 16); part += __shfl_xor(part, 32);
            if (fq == 0) ss[(size_t)row * 16 + u.pn * 4 + wc] = part;
        }
        asm volatile("" ::: "memory");
      }
    }
    return 16;
}

struct EpiIn {
    const float* ss; const float* bin; bf16_t* Z; float* gates; const float* ropec;
    __device__ __forceinline__ void pre(const UnitD& nu, int tid, LAS float* xb) const {
        pre_rstd(ss, nu, tid, xb);
        if (tid < 64) { const int c = tid * 4, col = nu.pn * BM + c;
            const f32x4 b = (nu.pn < 28) ? *(const f32x4*)(bin + (col < 3072 ? col : col + 1032)) : (c < 8 ? *(const f32x4*)(bin + 4096 + c) : (f32x4){0.f, 0.f, 0.f, 0.f});
            *(LAS f32x4*)(xb + 768 + c) = b; }
    }
    __device__ __forceinline__ int operator()(const AccT& acc, const UnitD& u, int wr, int wc, int fr, int fq, const LAS float* xb) const {
        f32x4 bv[2][2];
        FOR_BJ FOR_N bv[bj][n] = XB_BI(bj, n);
        float rs[2][4];
        FOR_AI FOR_M rs[ai][m] = XB_RS(ai, m);
        if (u.pn < 28) {
            if (u.pn >= 12 && u.pn < 20) {
                const float sc = u.pn >= 16 ? 0.0625f : 1.f;
                const float* ropes = ropec + (size_t)SEQ * 128;
                FOR_AI {
#pragma unroll
                    for (int mh = 0; mh < 2; ++mh) {
                        f32x4 cv[2][2], sv[2][2];
#pragma unroll
                        for (int mm = 0; mm < 2; ++mm) FOR_N { const size_t o = (size_t)(ROW(ai, mh * 2 + mm) & (SEQ - 1)) * 128 + wc * 32 + fq * 8 + n * 4; cv[mm][n] = *(const f32x4*)(ropec + o); sv[mm][n] = *(const f32x4*)(ropes + o); }
#pragma unroll
                        for (int mm = 0; mm < 2; ++mm) {
                            const int m = mh * 2 + mm;
                            f32x4 o1[2], o2[2];
                            FOR_N {
                                const f32x4 x1 = acc[ai][0][m][n] * rs[ai][m] + bv[0][n], x2 = acc[ai][1][m][n] * rs[ai][m] + bv[1][n];
                                o1[n] = (x1 * cv[mm][n] - x2 * sv[mm][n]) * sc; o2[n] = (x1 * sv[mm][n] + x2 * cv[mm][n]) * sc;
                            }
                            bf16_t* zr = Z + (size_t)ROW(ai, m) * ZW;
                            *(u32x4*)(zr + COL(0, 0)) = pack8(o1[0], o1[1]);
                            *(u32x4*)(zr + COL(1, 0)) = pack8(o2[0], o2[1]);
                        }
                        asm volatile("" ::: "memory");
                    }
                }
            } else {
                FOR_AI FOR_M FOR_BJ *(u32x4*)(Z + (size_t)ROW(ai, m) * ZW + COL(bj, 0)) = pack8(acc[ai][bj][m][0] * rs[ai][m] + bv[bj][0], acc[ai][bj][m][1] * rs[ai][m] + bv[bj][1]);
            }
            return 16;
        } else {
            const f32x4 b0 = bv[0][0], b1 = bv[0][1];
            if (wc == 0 && fq == 0) { FOR_AI FOR_M { float* gp = gates + (size_t)ROW(ai, m) * 8; *(f32x4*)gp = acc[ai][0][m][0] * rs[ai][m] + b0; *(f32x4*)(gp + 4) = acc[ai][0][m][1] * rs[ai][m] + b1; } }
            return 0;
        }
    }
};
struct EpiY {
    const float* ss; const float* bin; bf16_t* Z; const float* hstat; const float* mg; const float* rg;
    __device__ __forceinline__ void pre(const UnitD& nu, int tid, LAS float* xb) const {
        pre_rstd(ss, nu, tid, xb);
        const bool isM = nu.pn < 4; const int hidx = isM ? nu.pn : 4 + ((nu.pn - 4) >> 1);
        const float invw = __builtin_bit_cast(float, __builtin_amdgcn_readfirstlane(isM ? 0x3b800000 : 0x3b000000));
        const float* hp = hstat + ((size_t)(nu.pm * BM + (tid >> 1)) * 8 + hidx) * 16 + (tid & 1) * 8;
        f32x4 t = (f32x4){0.f, 0.f, 0.f, 0.f};
        if (!(isM && (tid & 1))) t = *(const f32x4*)hp + *(const f32x4*)(hp + 4);
        float sm = t[0] + t[2], q = t[1] + t[3];
        sm += __shfl_xor(sm, 1); q += __shfl_xor(q, 1);
        if ((tid & 1) == 0) { const float mu = sm * invw; xb[256 + (tid >> 1)] = mu; xb[512 + (tid >> 1)] = rsqrtf(fmaxf(q * invw - mu * mu, 0.f) + EPS); }
        pre_vec(bin + (isM ? 3072 : 7176) + nu.pn * BM, tid, xb + 768);
        pre_vec((isM ? mg : rg - 1024) + nu.pn * BM, tid, xb + 1024);
    }
    __device__ __forceinline__ int operator()(const AccT& acc, const UnitD& u, int wr, int wc, int fr, int fq, const LAS float* xb) const {
        const bool isM = u.pn < 4;
        FOR_AI {
            float rs[4], mu[4], hr[4];
            FOR_M { rs[m] = XB_RS(ai, m); mu[m] = XB_MU(ai, m); hr[m] = XB_HR(ai, m); }
            FOR_M {
                u32x4 hv[2];
                FOR_BJ { const int col = COL(bj, 0); hv[bj] = *(const u32x4*)(Z + (size_t)ROW(ai, m) * ZW + (isM ? 2048 + col : col + 4096)); }
                FOR_BJ {
                    const int col = COL(bj, 0);
                    const u32x4 w = hv[bj];
                    f32x4 hh[2];
                    FOR_N {
                        const f32x4 g = acc[ai][bj][m][n] * rs[m] + XB_BI(bj, n);
                        f32x4 gate = sigmoid4(g);
                        if (!isM) gate = gate * g;
                        const unsigned w0 = n ? w.z : w.x, w1 = n ? w.w : w.y;
                        const f32x4 h = (f32x4){bflo(w0), bfhi(w0), bflo(w1), bfhi(w1)};
                        hh[n] = (h - mu[m]) * hr[m] * XB_GN(bj, n) * gate;
                    }
                    *(u32x4*)(Z + (size_t)ROW(ai, m) * ZW + (isM ? 2048 + col : col + 4096)) = pack8(hh[0], hh[1]);
                }
                asm volatile("" ::: "memory");
            }
        }
        return 16;
    }
};
struct EpiMerge {
    const float* ss; const float* bin; bf16_t* Z; bf16_t* MG; int sub0;
    __device__ __forceinline__ void pre(const UnitD& nu, int tid, LAS float* xb) const {
        const int sub = nu.sub + sub0;
        if (sub == 0 || sub == 2) { pre_rstd(ss, nu, tid, xb); pre_vec(bin + (sub == 0 ? 10248 : 11272) + nu.pn * BM, tid, xb + 768); }
    }
    __device__ __forceinline__ int operator()(const AccT& acc, const UnitD& u, int wr, int wc, int fr, int fq, const LAS float* xb) const {
        const int sub = u.sub + sub0;
        if (sub == 0 || sub == 2) {
            const int toff = (sub == 0) ? 0 : 1024;
            f32x4 bv[2][2];
            FOR_BJ FOR_N bv[bj][n] = XB_BI(bj, n);
            float rs[2][4];
            FOR_AI FOR_M rs[ai][m] = XB_RS(ai, m);
            FOR_AI FOR_M FOR_BJ *(u32x4*)(Z + (size_t)ROW(ai, m) * ZW + toff + COL(bj, 0)) = pack8(sigmoid4(acc[ai][bj][m][0] * rs[ai][m] + bv[bj][0]), sigmoid4(acc[ai][bj][m][1] * rs[ai][m] + bv[bj][1]));
        } else if (sub == 1) {
            FOR_AI {
#pragma unroll
                for (int mh = 0; mh < 2; ++mh) {
                    u32x4 tv[2][2];
#pragma unroll
                    for (int mm = 0; mm < 2; ++mm) FOR_BJ tv[mm][bj] = *(const u32x4*)(Z + (size_t)ROW(ai, mh * 2 + mm) * ZW + COL(bj, 0));
#pragma unroll
                    for (int mm = 0; mm < 2; ++mm) FOR_BJ { const int m = mh * 2 + mm; f32x4 t0, t1; unpack8(tv[mm][bj], t0, t1); *(u32x4*)(Z + (size_t)ROW(ai, m) * ZW + COL(bj, 0)) = pack8(t0 * acc[ai][bj][m][0], t1 * acc[ai][bj][m][1]); }
                    asm volatile("" ::: "memory");
                }
            }
        } else {
            FOR_AI {
#pragma unroll
                for (int mh = 0; mh < 2; ++mh) {
                    u32x4 ta[2][2], tb[2][2];
#pragma unroll
                    for (int mm = 0; mm < 2; ++mm) FOR_BJ { const bf16_t* zr = Z + (size_t)ROW(ai, mh * 2 + mm) * ZW + COL(bj, 0); ta[mm][bj] = *(const u32x4*)zr; tb[mm][bj] = *(const u32x4*)(zr + 1024); }
#pragma unroll
                    for (int mm = 0; mm < 2; ++mm) FOR_BJ {
                        const int m = mh * 2 + mm;
                        f32x4 a0, a1, b0, b1; unpack8(ta[mm][bj], a0, a1); unpack8(tb[mm][bj], b0, b1);
                        *(u32x4*)(MG + (size_t)ROW(ai, m) * DM + COL(bj, 0)) = pack8(a0 + b0 * acc[ai][bj][m][0], a1 + b1 * acc[ai][bj][m][1]);
                    }
                    asm volatile("" ::: "memory");
                }
            }
        }
        return 16;
    }
};
struct EpiX {
    const bf16_t* xin; bf16_t* xout; float* ss; const float* bias;
    __device__ __forceinline__ void pre(const UnitD&, int, LAS float*) const {}
    __device__ __forceinline__ int operator()(const AccT& acc, const UnitD& u, int wr, int wc, int fr, int fq, const LAS float* xb) const {
        if (bias) return x_update<true, false>(acc, u, wr, wc, fr, fq, xin, xout, ss, bias, nullptr);
        return x_update<false, false>(acc, u, wr, wc, fr, fq, xin, xout, ss, nullptr, nullptr);
    }
};
struct EpiFF1 {
    const float* ss; const float* b1; bf16_t* H;
    __device__ __forceinline__ void pre(const UnitD& nu, int tid, LAS float* xb) const { pre_rstd(ss, nu, tid, xb); pre_vec(b1 + nu.pn * BM, tid, xb + 768); }
    __device__ __forceinline__ int operator()(const AccT& acc, const UnitD& u, int wr, int wc, int fr, int fq, const LAS float* xb) const {
        f32x4 bv[2][2];
        FOR_BJ FOR_N bv[bj][n] = XB_BI(bj, n);
        float rs[2][4];
        FOR_AI FOR_M rs[ai][m] = XB_RS(ai, m);
        FOR_AI FOR_M FOR_BJ {
            f32x4 vv[2];
            FOR_N {
                f32x4 v = acc[ai][bj][m][n] * rs[ai][m] + bv[bj][n];
                v = (f32x4){fmaxf(v[0], 0.f), fmaxf(v[1], 0.f), fmaxf(v[2], 0.f), fmaxf(v[3], 0.f)};
                vv[n] = v * v;
            }
            *(u32x4*)(H + (size_t)ROW(ai, m) * FF + COL(bj, 0)) = pack8(vv[0], vv[1]);
        }
        return 16;
    }
};
struct EpiPE {
    const float* ssr; bf16_t* T; const bf16_t* xin; bf16_t* xout; float* ssw;
    __device__ __forceinline__ void pre(const UnitD& nu, int tid, LAS float* xb) const { if (nu.sub == 0) pre_rstd(ssr, nu, tid, xb); }
    __device__ __forceinline__ int operator()(const AccT& acc, const UnitD& u, int wr, int wc, int fr, int fq, const LAS float* xb) const {
        if (u.sub == 0) {
            float rs[2][4];
            FOR_AI FOR_M rs[ai][m] = XB_RS(ai, m);
            FOR_AI FOR_M FOR_BJ *(u32x4*)(T + (size_t)ROW(ai, m) * DM + COL(bj, 0)) = pack8(sigmoid4(acc[ai][bj][m][0] * rs[ai][m]), sigmoid4(acc[ai][bj][m][1] * rs[ai][m]));
            return 16;
        }
        return x_update<false, true>(acc, u, wr, wc, fr, fq, xin, xout, ssw, nullptr, T);
    }
};

__device__ __forceinline__ void tr_item(const float* W, int ldw, int col0, const float* gs, int K, bf16_t* WT, int nrow0, LAS float* scr, int kb, int lane, int nvalid) {
    const int k0 = 64 * kb;
#pragma unroll 8
    for (int i = 0; i < 32; ++i) {
        const int kk = 2 * i + (lane >> 5), n = lane & 31;
        float v = (n < nvalid) ? W[(size_t)(k0 + kk) * ldw + col0 + n] : 0.f;
        if (gs) v *= gs[k0 + kk];
        scr[kk * 33 + n] = v;
    }
    LDS_WAIT(); asm volatile("" ::: "memory");
    const int c = lane & 7;
#pragma unroll
    for (int j = 0; j < 4; ++j) {
        const int n = (lane >> 3) + 8 * j; const LAS float* s = scr + (8 * c) * 33 + n;
        u32x4 o; o.x = cvt_pk_bf16(s[0 * 33], s[1 * 33]); o.y = cvt_pk_bf16(s[2 * 33], s[3 * 33]); o.z = cvt_pk_bf16(s[4 * 33], s[5 * 33]); o.w = cvt_pk_bf16(s[6 * 33], s[7 * 33]);
        *(u32x4*)(WT + (size_t)(nrow0 + n) * K + k0 + 8 * c) = o;
    }
    LDS_WAIT(); asm volatile("" ::: "memory");
}

__device__ __forceinline__ void prep_phase(const Params& P, int l, int grp, bf16_t* WY, bf16_t* WGM, bf16_t* WGR, LAS unsigned char* lds, int gwb, int NGW, const int tid) {
    const int lane = tid & 63, wave = __builtin_amdgcn_readfirstlane(tid >> 6);
    const int gw = gwb + wave;
    LAS float* scr = (LAS float*)(lds + wave * 16384);
    unsigned char* ws = P.ws;
    bf16_t* W1 = (bf16_t*)(ws + WS_W1);
    bf16_t* WBM = (bf16_t*)(ws + WS_WBM); bf16_t* WBR = (bf16_t*)(ws + WS_WBR); bf16_t* WOUT = (bf16_t*)(ws + WS_WOUT); bf16_t* WFF1 = (bf16_t*)(ws + WS_WFF1);
    bf16_t* WFF2 = (bf16_t*)(ws + WS_WFF2); bf16_t* WPG = (bf16_t*)(ws + WS_WPG); bf16_t* WPE = (bf16_t*)(ws + WS_WPE);
    const float* win = P.w_in + (size_t)l * DM * NIN; const float* g1 = P.norm1_g + l * DM; const float* g2 = P.norm2_g + l * DM; const float* g3 = P.norm3_g + l * DM;
    constexpr int I0 = 16 * 96, I1 = 16 * 128, I2 = 16 * 8, I3 = 16 * 32, I4 = 16 * 64, I5 = 512, I6 = 512, I7 = 512, I8 = 32 * 32, I9 = 512, I10 = 16 * 128, I11 = 64 * 32, I12 = 512, I13 = 4 * 32;
    constexpr int NA = I0 + I1 + I2 + I3 + I4 + I5 + I6, NITEMS = NA + I7 + I8 + I9 + I10 + I11 + I12 + I13;
    const int it_lo = grp == 0 ? 0 : NA, it_hi = grp == 0 ? NA : NITEMS;
    for (int it = it_lo + gw; it < it_hi; it += NGW) {
        int r = it;
        if (r < I0) { const int kb = r / 96, nb = r % 96; tr_item(win, NIN, 32 * nb, g1, DM, W1, 32 * nb, scr, kb, lane, 32); continue; } r -= I0;
        if (r < I1) { const int kb = r / 128, nb = r % 128; tr_item(win, NIN, 4104 + 32 * nb, g1, DM, W1, 3072 + 32 * nb, scr, kb, lane, 32); continue; } r -= I1;
        if (r < I2) { const int kb = r / 8, nb = r % 8; tr_item(win, NIN, 4096, g1, DM, W1, 7168 + 32 * nb, scr, kb, lane, nb == 0 ? 8 : 0); continue; } r -= I2;
        if (r < I3) { const int kb = r / 32, nb = r % 32; tr_item(win, NIN, 3072 + 32 * nb, g1, DM, WY, 32 * nb, scr, kb, lane, 32); continue; } r -= I3;
        if (r < I4) { const int kb = r / 64, nb = r % 64; tr_item(win, NIN, 8200 + 32 * nb, g1, DM, WY, 1024 + 32 * nb, scr, kb, lane, 32); continue; } r -= I4;
        if (r < I5) { const int kb = r / 32, nb = r % 32; tr_item(win, NIN, 10248 + 32 * nb, g1, DM, WGM, 32 * nb, scr, kb, lane, 32); continue; } r -= I5;
        if (r < I6) { const int kb = r / 32, nb = r % 32; tr_item(win, NIN, 11272 + 32 * nb, g1, DM, WGR, 32 * nb, scr, kb, lane, 32); continue; } r -= I6;
        if (r < I7) { const int kb = r / 32, nb = r % 32; tr_item(P.w_bm + (size_t)l * 1024 * DM, DM, 32 * nb, nullptr, 1024, WBM, 32 * nb, scr, kb, lane, 32); continue; } r -= I7;
        if (r < I8) { const int kb = r / 32, nb = r % 32; tr_item(P.w_br + (size_t)l * 2048 * DM, DM, 32 * nb, nullptr, 2048, WBR, 32 * nb, scr, kb, lane, 32); continue; } r -= I8;
        if (r < I9) { const int kb = r / 32, nb = r % 32; tr_item(P.w_out + (size_t)l * DM * DM, DM, 32 * nb, nullptr, DM, WOUT, 32 * nb, scr, kb, lane, 32); continue; } r -= I9;
        if (r < I10) { const int kb = r / 128, nb = r % 128; tr_item(P.w_ff1 + (size_t)l * DM * FF, FF, 32 * nb, g2, DM, WFF1, 32 * nb, scr, kb, lane, 32); continue; } r -= I10;
        if (r < I11) { const int kb = r / 32, nb = r % 32; tr_item(P.w_ff2 + (size_t)l * FF * DM, DM, 32 * nb, nullptr, FF, WFF2, 32 * nb, scr, kb, lane, 32); continue; } r -= I11;
        if (r < I12) { const int kb = r / 32, nb = r % 32; tr_item(P.w_pe_gate + (size_t)l * DM * DM, DM, 32 * nb, g3, DM, WPG, 32 * nb, scr, kb, lane, 32); continue; } r -= I12;
        { const int kb = r / 32, nb = r % 32; tr_item(P.w_pe + (size_t)l * PED * DM, DM, 32 * nb, nullptr, PED, WPE, 32 * nb, scr, kb, lane, 32); }
    }
}

__device__ __forceinline__ void pconv_phase(const Params& P, int l, int gwb, int NGW, const int tid) {
    const int lane = tid & 63, wave = __builtin_amdgcn_readfirstlane(tid >> 6);
    const int gw = gwb + wave;
    unsigned char* ws = P.ws;
    {
        const float* pl = P.p + (size_t)l * NTOK * PED; bf16_t* PB = (bf16_t*)(ws + WS_PB);
        const size_t nchunk = (size_t)NTOK * PED / 8;
        for (size_t i = (size_t)gw * 64 + lane; i < nchunk; i += (size_t)NGW * 64) {
            const f32x4 a = *(const f32x4*)(pl + i * 8), b = *(const f32x4*)(pl + i * 8 + 4);
            u32x4 o; o.x = cvt_pk_bf16(a[0], a[1]); o.y = cvt_pk_bf16(a[2], a[3]); o.z = cvt_pk_bf16(b[0], b[1]); o.w = cvt_pk_bf16(b[2], b[3]);
            *(u32x4*)(PB + i * 8) = o;
        }
    }
}

__device__ __forceinline__ void prep0_phase(const Params& P, int vcu, int G, const int tid) {
    const int lane = tid & 63, wave = __builtin_amdgcn_readfirstlane(tid >> 6);
    const int gw = vcu * 8 + wave, NGW = G * 8;
    unsigned char* ws = P.ws;
    {
        bf16_t* XB = (bf16_t*)(ws + WS_XB0); float* ss = (float*)(ws + WS_SS0);
        for (int row = gw; row < NTOK; row += NGW) {
            const f32x4* xr = (const f32x4*)(P.x + (size_t)row * DM) + lane;
            float s = 0.f;
#pragma unroll
            for (int j = 0; j < 4; ++j) {
                const f32x4 v = xr[64 * j];
                s += (v[0] * v[0] + v[1] * v[1]) + (v[2] * v[2] + v[3] * v[3]);
                *((u32x2*)(XB + (size_t)row * DM) + lane + 64 * j) = pack4(v);
            }
#pragma unroll
            for (int o = 1; o < 64; o <<= 1) s += __shfl_xor(s, o);
            if (lane < 16) ss[(size_t)row * 16 + lane] = (lane == 0) ? s : 0.f;
        }
        float* rc = (float*)(ws + WS_ROPE); float* rsn = rc + (size_t)SEQ * 128;
        for (int i = (vcu * 512 + tid); i < SEQ * 128; i += G * 512) {
            const int pos = i >> 7, j = i & 127;
            const double invf = exp2(-(double)j * (13.287712379549449 / 128.0));
            double ang = (double)pos * invf;
            const double k = rint(ang * 0.15915494309189535);
            ang = ang - k * 6.283185307179586;
            const float af = (float)ang;
            rc[i] = cosf(af); rsn[i] = sinf(af);
        }
    }
}

constexpr int QP = 544, VP = 144, VRP = 208, OBP = 336;
constexpr int S_Q = 0, S_K = 34816, S_ST = 69632, S_VT = 113152, S_VW = 126464, S_P = 139776, S_VEC = 148992;
static_assert(S_K == 64 * QP && S_ST == 2 * 64 * QP && S_VT == S_ST + 80 * QP && S_VW == S_VT + 64 * VRP && S_P == S_VW + 64 * VRP && S_VEC == S_P + 64 * VP && S_VEC + 1024 <= LDS_BYTES - 64, "scan LDS map");
__device__ __forceinline__ s16x4 tr_read(const LAS unsigned char* p) {
    typedef short v4i16_t __attribute__((ext_vector_type(4)));
    return __builtin_bit_cast(s16x4, __builtin_amdgcn_ds_read_tr16_b64_v4i16((LAS v4i16_t*)p));
}

#define MFMA16(a, b, c) __builtin_amdgcn_mfma_f32_16x16x32_bf16((a), (b), (c), 0, 0, 0)
__device__ __forceinline__ void prescan_phase(const Params& P, int l, bf16_t* QC, bf16_t* KC, const bf16_t* XB, const float* ss, LAS unsigned char* lds, int vcu, int G, const int tid) {
    const int lane = tid & 63, wave = __builtin_amdgcn_readfirstlane(tid >> 6);
    bf16_t* Z = (bf16_t*)(P.ws + WS_Z);
    const int gt = vcu * 512 + tid, NT = G * 512;
    for (int it = gt; it < (NTOK / 4) * 256; it += NT) {
        const int cc = it & 255, tgp = it >> 8, ch = cc * 8, mat = ch >> 10, rowb = 4 * tgp, pos0 = rowb & (SEQ - 1);
        const float* cw = P.conv_w + (size_t)l * 8192 + ch; const float* cb = P.conv_b + (size_t)l * 2048 + ch;
        u32x4 raw[7];
#pragma unroll
        for (int i = 0; i < 7; ++i) {
            raw[i] = (u32x4){0u, 0u, 0u, 0u};
            if (pos0 - 3 + i >= 0) raw[i] = *(const u32x4*)(Z + (size_t)(rowb - 3 + i) * ZW + ch);
        }
        f32x4 wv[4][2], bb[2];
#pragma unroll
        for (int j = 0; j < 4; ++j) { wv[j][0] = *(const f32x4*)(cw + j * 2048); wv[j][1] = *(const f32x4*)(cw + j * 2048 + 4); }
        bb[0] = *(const f32x4*)cb; bb[1] = *(const f32x4*)(cb + 4);
        bf16_t* dst = (mat ? KC : QC) + (size_t)rowb * 1024 + (ch & 1023);
        const float sc = mat ? 1.f : 0.0625f;
#pragma unroll
        for (int tt = 0; tt < 4; ++tt) {
            f32x4 o0 = bb[0], o1 = bb[1];
#pragma unroll
            for (int j = 0; j < 4; ++j) {
                const u32x4 rw = raw[tt + j];
                o0 = o0 + wv[j][0] * (f32x4){bflo(rw.x), bfhi(rw.x), bflo(rw.y), bfhi(rw.y)};
                o1 = o1 + wv[j][1] * (f32x4){bflo(rw.z), bfhi(rw.z), bflo(rw.w), bfhi(rw.w)};
            }
            o0 = o0 * sigmoid4(o0) * sc; o1 = o1 * sigmoid4(o1) * sc;
            u32x4 pk; pk.x = cvt_pk_bf16(o0[0], o0[1]); pk.y = cvt_pk_bf16(o0[2], o0[3]); pk.z = cvt_pk_bf16(o1[0], o1[1]); pk.w = cvt_pk_bf16(o1[2], o1[3]);
            *(u32x4*)(dst + (size_t)tt * 1024) = pk;
        }
    }
    {
        const int r = lane & 15, q = lane >> 4;
        const bf16_t* Wg = (const bf16_t*)(P.ws + WS_W1) + (size_t)7168 * DM;
        const float* bin = P.b_in + (size_t)l * NIN;
        LAS float* gsc = (LAS float*)lds;
        f32x4* GV = (f32x4*)(P.ws + WS_GV);
        for (int blk = vcu; blk < NTOK / 128; blk += G) {
            const int rowt = blk * 128 + wave * 16 + r;
            f32x4 acc = (f32x4){0.f, 0.f, 0.f, 0.f};
            const bf16_t* wp = Wg + (size_t)r * DM + q * 8; const bf16_t* xp = XB + (size_t)rowt * DM + q * 8;
#pragma unroll 16
            for (int kk = 0; kk < 32; ++kk) acc = MFMA16(*(const bf16x8*)(wp + kk * 32), *(const bf16x8*)(xp + kk * 32), acc);
            const f32x4 bv = (q < 2) ? *(const f32x4*)(bin + 4096 + 4 * q) : (f32x4){0.f, 0.f, 0.f, 0.f};
            const f32x4 pv = *(const f32x4*)(ss + (size_t)rowt * 16 + q * 4);
            float sq = (pv[0] + pv[1]) + (pv[2] + pv[3]);
            sq += __shfl_xor(sq, 16); sq += __shfl_xor(sq, 32);
            const float rs = rsqrtf(sq * (1.f / DM) + EPS);
            if (q < 2) {
#pragma unroll
                for (int j = 0; j < 4; ++j) gsc[(4 * q + j) * 128 + wave * 16 + r] = acc[j] * rs + bv[j];
            }
            __syncthreads();
            {
                const int c = wave >> 2, h = wave & 3;
                const float li = gsc[h * 128 + c * 64 + lane], mf = gsc[(4 + h) * 128 + c * 64 + lane];
                const float lf = fminf(mf, 0.f) - log1pf(expf(-fabsf(mf)));
                float bcs = lf;
#pragma unroll
                for (int o = 1; o < 64; o <<= 1) { const float v = __shfl_up(bcs, o); if (lane >= o) bcs += v; }
                const float a = li - bcs;
                float pm = a;
#pragma unroll
                for (int o = 1; o < 64; o <<= 1) { const float v = __shfl_up(pm, o); if (lane >= o) pm = fmaxf(pm, v); }
                GV[(size_t)(blk * 128 + c * 64 + lane) * 4 + h] = (f32x4){a, pm, bcs, 0.f};
            }
            __syncthreads();
        }
    }
}

__device__ __forceinline__ void scan_phase(const Params& P, int l, const bf16_t* QC, const bf16_t* KC, LAS unsigned char* lds, int vcu, const int tid) {
    if (vcu >= 192) return;
    const int lane = tid & 63, wid = __builtin_amdgcn_readfirstlane(tid >> 6), r = lane & 15, q = lane >> 4;
    const bool isM = vcu < 64;
    int bh, slice; if (isM) { bh = vcu >> 2; slice = vcu & 3; } else { const int t = vcu - 64; bh = t >> 3; slice = t & 7; }
    const int b = bh >> 2, h = bh & 3;
    const int vcol = isM ? 2048 + h * 256 + slice * 64 : 5120 + h * 512 + slice * 64;
    const int hidx = isM ? h : 4 + h;
    bf16_t* Z = (bf16_t*)(P.ws + WS_Z);
    const f32x4* GV = (const f32x4*)(P.ws + WS_GV);
    float* hstat = (float*)(P.ws + WS_HSTAT);
    const bf16_t* qsrc = isM ? QC + (size_t)b * SEQ * 1024 + h * 256 : Z + (size_t)b * SEQ * ZW + 3072 + h * 256;
    const bf16_t* ksrc = isM ? KC + (size_t)b * SEQ * 1024 + h * 256 : Z + (size_t)b * SEQ * ZW + 4096 + h * 256;
    const size_t qkp = isM ? 1024 : ZW;
    LAS unsigned char* SQ = lds + S_Q; LAS unsigned char* SK = lds + S_K; LAS unsigned char* SST = lds + S_ST; LAS unsigned char* SVT = lds + S_VT;
    LAS unsigned char* SVW = lds + S_VW; LAS unsigned char* SP = lds + S_P; LAS unsigned char* OB = lds + S_Q;
    LAS float* vecU = (LAS float*)(lds + S_VEC); LAS float* vecA = vecU + 64; LAS float* vecDI = vecU + 128; LAS float* vecEN = vecU + 192;
    { unsigned zz = 0u; asm volatile("" : "+v"(zz)); const u32x4 z4 = (u32x4){zz, zz, zz, zz};
      for (int i = tid; i < (S_P - S_ST) / 16; i += 512) *(LAS u32x4*)(SST + i * 16) = z4; }
    __syncthreads();
    if (isM && tid < 64) *(LAS bf16_t*)(SVT + tid * VRP + 128) = (bf16_t)0x3F80;
    f32x4 accS[2][5];
#pragma unroll
    for (int i = 0; i < 2; ++i)
#pragma unroll
        for (int v = 0; v < 5; ++v) accS[i][v] = (f32x4){0.f, 0.f, 0.f, 0.f};
    float m_prev = 0.f;
    const float lg = logf(1.f - exp2f(-5.f - (float)h));
    const float r_u = (float)lane * lg, r_a = -(float)lane * lg, r_di = expf((float)(lane + 1) * lg), r_w = expf((float)(63 - lane) * lg), r_dec = expf(64.f * lg);
    u32x4 pq[4], pk[4], pv; f32x4 pg = (f32x4){0.f, 0.f, 0.f, 0.f};
    const int lt = tid >> 5, lc = tid & 31;
#define SCAN_ISSUE(c_) do { const size_t rb_ = (size_t)(c_) * 64; \
        _Pragma("unroll") for (int i_ = 0; i_ < 4; ++i_) { pq[i_] = *(const u32x4*)(qsrc + (rb_ + lt + 16 * i_) * qkp + lc * 8); pk[i_] = *(const u32x4*)(ksrc + (rb_ + lt + 16 * i_) * qkp + lc * 8); } \
        pv = *(const u32x4*)(Z + ((size_t)b * SEQ + rb_ + (tid >> 3)) * ZW + vcol + (tid & 7) * 8); \
        if (isM) pg = GV[((size_t)b * SEQ + rb_ + lane) * 4 + h]; } while (0)
    SCAN_ISSUE(0);
    __syncthreads();
#define SCAN_BAR() asm volatile("s_waitcnt lgkmcnt(0)\n\ts_barrier" ::: "memory")

    for (int c = 0; c < SEQ / 64; ++c) {
        const int row0 = b * SEQ + c * 64;
        float u_t, a_s, di, en, w, decay, m_new;
        if (isM) {
            const float a = pg[0] + pg[3], pm = pg[1], bcs = pg[2];
            const float Mt = fmaxf(m_prev, pm);
            u_t = -Mt; a_s = a; di = __expf(m_prev - Mt); en = __expf(-(bcs + Mt));
            const float Mend = __builtin_bit_cast(float, __builtin_amdgcn_readlane(__builtin_bit_cast(int, Mt), 63));
            const float bend = __builtin_bit_cast(float, __builtin_amdgcn_readlane(__builtin_bit_cast(int, bcs), 63));
            w = __expf(a - Mend); decay = __expf(m_prev - Mend); m_new = bend + Mend;
        } else { u_t = r_u; a_s = r_a; di = r_di; en = 1.f; w = r_w; decay = r_dec; m_new = 0.f; }
        if (wid == 0) { vecU[lane] = u_t; vecA[lane] = a_s; vecDI[lane] = di; vecEN[lane] = en; }
#pragma unroll
        for (int i = 0; i < 4; ++i) { *(LAS u32x4*)(SQ + (lt + 16 * i) * QP + lc * 16) = pq[i]; *(LAS u32x4*)(SK + (lt + 16 * i) * QP + lc * 16) = pk[i]; }
        {
            const int vs = tid >> 3, vch = tid & 7;
            const float ws = __shfl(w, vs);
            *(LAS u32x4*)(SVT + vs * VRP + vch * 16) = pv;
            u32x4 pw; pw.x = cvt_pk_bf16(bflo(pv.x) * ws, bfhi(pv.x) * ws); pw.y = cvt_pk_bf16(bflo(pv.y) * ws, bfhi(pv.y) * ws);
            pw.z = cvt_pk_bf16(bflo(pv.z) * ws, bfhi(pv.z) * ws); pw.w = cvt_pk_bf16(bflo(pv.w) * ws, bfhi(pv.w) * ws);
            *(LAS u32x4*)(SVW + vs * VRP + vch * 16) = pw;
            if (isM && wid == 0) *(LAS bf16_t*)(SVW + lane * VRP + 128) = (bf16_t)(cvt_pk_bf16(w, 0.f) & 0xffffu);
        }
        if (c + 1 < SEQ / 64) SCAN_ISSUE(c + 1);
        SCAN_BAR();
        {
            const int sm = wid >> 1, tn0 = (wid & 1) * 2;
            f32x4 sa[2] = {(f32x4){0.f, 0.f, 0.f, 0.f}, (f32x4){0.f, 0.f, 0.f, 0.f}};
            if (sm <= tn0 + 1) {
#pragma unroll
                for (int kb = 0; kb < 2; ++kb) {
                    bf16x8 fa[4], fb0[4], fb1[4];
#pragma unroll
                    for (int j = 0; j < 4; ++j) {
                        const int kk = kb * 4 + j;
                        fa[j] = *(const LAS bf16x8*)(SK + (sm * 16 + r) * QP + kk * 64 + q * 16);
                        fb0[j] = *(const LAS bf16x8*)(SQ + (tn0 * 16 + r) * QP + kk * 64 + q * 16);
                        fb1[j] = *(const LAS bf16x8*)(SQ + ((tn0 + 1) * 16 + r) * QP + kk * 64 + q * 16);
                    }
#pragma unroll
                    for (int j = 0; j < 4; ++j) { sa[0] = MFMA16(fa[j], fb0[j], sa[0]); sa[1] = MFMA16(fa[j], fb1[j], sa[1]); }
                }
            }
            const int s0 = sm * 16 + 4 * q;
            const f32x4 a4 = *(const LAS f32x4*)(vecA + s0);
#pragma unroll
            for (int i = 0; i < 2; ++i) {
                const int t = (tn0 + i) * 16 + r; const float ut = vecU[t];
                f32x4 pv;
#pragma unroll
                for (int j = 0; j < 4; ++j) pv[j] = (s0 + j <= t) ? sa[i][j] * __expf(ut + a4[j]) : 0.f;
                *(LAS u32x2*)(SP + t * VP + s0 * 2) = pack4(pv);
            }
        }
        SCAN_BAR();
        const int tn = wid & 3, vt0 = (wid >> 2) ? 3 : 0, nvt = (wid >> 2) ? 2 : 3;
        f32x4 oo[3];
        {
            f32x4 o1[3], o2[3];
#pragma unroll
            for (int i = 0; i < 3; ++i) { o1[i] = (f32x4){0.f, 0.f, 0.f, 0.f}; o2[i] = (f32x4){0.f, 0.f, 0.f, 0.f}; }
#pragma unroll
            for (int ks = 0; ks < 2; ++ks) {
                const bf16x8 bP = *(const LAS bf16x8*)(SP + (tn * 16 + r) * VP + ks * 64 + q * 16);
#pragma unroll
                for (int i = 0; i < 3; ++i) if (i < nvt) {
                    const LAS unsigned char* vb = SVT + (32 * ks + 8 * q + ((lane & 15) >> 2)) * VRP + (16 * (vt0 + i)) * 2 + 8 * (lane & 3);
                    const s16x4 vlo = tr_read(vb), vhi = tr_read(vb + 4 * VRP);
                    const bf16x8 aV = __builtin_shufflevector(vlo, vhi, 0, 1, 2, 3, 4, 5, 6, 7);
                    o1[i] = MFMA16(aV, bP, o1[i]);
                }
            }
#pragma unroll
            for (int kb = 0; kb < 4; ++kb) {
                bf16x8 fq[2], fs[2][3];
#pragma unroll
                for (int j = 0; j < 2; ++j) {
                    const int kk = kb * 2 + j;
                    fq[j] = *(const LAS bf16x8*)(SQ + (tn * 16 + r) * QP + kk * 64 + q * 16);
#pragma unroll
                    for (int i = 0; i < 3; ++i) if (i < nvt) fs[j][i] = *(const LAS bf16x8*)(SST + ((vt0 + i) * 16 + r) * QP + kk * 64 + q * 16);
                }
#pragma unroll
                for (int j = 0; j < 2; ++j)
#pragma unroll
                    for (int i = 0; i < 3; ++i) if (i < nvt) o2[i] = MFMA16(fs[j][i], fq[j], o2[i]);
            }
            const float dit = vecDI[tn * 16 + r];
#pragma unroll
            for (int i = 0; i < 3; ++i) oo[i] = o1[i] + o2[i] * dit;
        }
        {
#pragma unroll
            for (int i = 0; i < 2; ++i)
#pragma unroll
                for (int v = 0; v < 5; ++v) accS[i][v] = accS[i][v] * decay;
            const int qq = (lane & 15) >> 2, pp = lane & 3;
#pragma unroll
            for (int ks = 0; ks < 2; ++ks) {
                bf16x8 aK[2];
#pragma unroll
                for (int i = 0; i < 2; ++i) {
                    const LAS unsigned char* base = SK + (32 * ks + 8 * q + qq) * QP + (16 * (2 * wid + i)) * 2 + 8 * pp;
                    const s16x4 lo = tr_read(base), hi = tr_read(base + 4 * QP);
                    aK[i] = __builtin_shufflevector(lo, hi, 0, 1, 2, 3, 4, 5, 6, 7);
                }
#pragma unroll
                for (int v = 0; v < 5; ++v) {
                    const LAS unsigned char* wb = SVW + (32 * ks + 8 * q + qq) * VRP + (16 * v) * 2 + 8 * pp;
                    const s16x4 wlo = tr_read(wb), whi = tr_read(wb + 4 * VRP);
                    const bf16x8 bV = __builtin_shufflevector(wlo, whi, 0, 1, 2, 3, 4, 5, 6, 7);
                    accS[0][v] = MFMA16(aK[0], bV, accS[0][v]); accS[1][v] = MFMA16(aK[1], bV, accS[1][v]);
                }
            }
        }
        SCAN_BAR();
#pragma unroll
        for (int i = 0; i < 3; ++i) if (i < nvt) *(LAS f32x4*)(OB + (tn * 16 + r) * OBP + ((vt0 + i) * 16 + 4 * q) * 4) = oo[i];
#pragma unroll
        for (int i = 0; i < 2; ++i)
#pragma unroll
            for (int v = 0; v < 5; ++v) *(LAS u32x2*)(SST + (v * 16 + r) * QP + ((2 * wid + i) * 16 + 4 * q) * 2) = pack4(accS[i][v]);
        SCAN_BAR();
        {
            const int t = tid >> 3, vc = tid & 7;
            f32x4 n0 = *(const LAS f32x4*)(OB + t * OBP + vc * 32), n1 = *(const LAS f32x4*)(OB + t * OBP + vc * 32 + 16);
            if (isM) {
                const float den = *(const LAS float*)(OB + t * OBP + 256);
                const float inv = 1.f / fmaxf(fabsf(den), vecEN[t]);
                n0 = n0 * inv; n1 = n1 * inv;
            }
            float s = (n0[0] + n0[1]) + (n0[2] + n0[3]) + (n1[0] + n1[1]) + (n1[2] + n1[3]);
            float sq = (n0[0] * n0[0] + n0[1] * n0[1]) + (n0[2] * n0[2] + n0[3] * n0[3]) + (n1[0] * n1[0] + n1[1] * n1[1]) + (n1[2] * n1[2] + n1[3] * n1[3]);
            s += __shfl_xor(s, 1); s += __shfl_xor(s, 2); s += __shfl_xor(s, 4);
            sq += __shfl_xor(sq, 1); sq += __shfl_xor(sq, 2); sq += __shfl_xor(sq, 4);
            if (vc == 0) *(f32x2*)(hstat + ((size_t)(row0 + t) * 8 + hidx) * 16 + slice * 2) = (f32x2){s, sq};
            u32x4 pk; pk.x = cvt_pk_bf16(n0[0], n0[1]); pk.y = cvt_pk_bf16(n0[2], n0[3]); pk.z = cvt_pk_bf16(n1[0], n1[1]); pk.w = cvt_pk_bf16(n1[2], n1[3]);
            *(u32x4*)(Z + (size_t)(row0 + t) * ZW + vcol + vc * 8) = pk;
        }
        m_prev = m_new;
        SCAN_BAR();
    }
}


#define XB_TMO      128
#define XB_XCNT(j)  (256  + 64 * (j))
#define XB_XSUB(j)  (1280 + 64 * (j))
#define XB_XGEN(j)  (2304 + 64 * (j))
#define XB_TOP      3328
#define XB_TOPGEN   3392
#define XCD_BAR_WORDS 3456
#define XB_SPIN_CAP (1u << 18)
__device__ __forceinline__ unsigned xb_ld(unsigned* p)              { return __hip_atomic_load(p, __ATOMIC_RELAXED, __HIP_MEMORY_SCOPE_AGENT); }
__device__ __forceinline__ unsigned xb_add(unsigned* p, unsigned v) { return __hip_atomic_fetch_add(p, v, __ATOMIC_RELAXED, __HIP_MEMORY_SCOPE_AGENT); }
__device__ __forceinline__ unsigned xb_xcc_id() { return (unsigned)__builtin_amdgcn_s_getreg((3 << 11) | 20) & 0xFu; }
#define XB_SPIN(cond, bar) do { unsigned _sp = 0; while (cond) { __builtin_amdgcn_s_sleep(1); \
    if ((++_sp & 255u) == 0u) { if (xb_ld(&(bar)[XB_TMO])) break; if (_sp > XB_SPIN_CAP) { atomicAdd(&(bar)[XB_TMO], 1u); break; } } } } while (0)
struct XcdBarrier { unsigned* bar; unsigned x; volatile LAS unsigned* st; };
__device__ __forceinline__ XcdBarrier xcd_barrier_post(unsigned* bar, volatile LAS unsigned* st, const bool t0) {
    XcdBarrier b; b.bar = bar; b.x = xb_xcc_id(); b.st = st;
    if (t0) (void)xb_add(&bar[XB_XCNT(b.x)], 1u);
    return b;
}
__device__ __forceinline__ void xcd_barrier_complete(unsigned* bar, unsigned x, unsigned& nloc, unsigned& nx) {
    const unsigned G = gridDim.x * gridDim.y * gridDim.z;
    unsigned sum, cnt, mine, sp = 0u;
    for (;;) {
        sum = 0u; cnt = 0u; mine = 0u;
#pragma unroll
        for (unsigned j = 0; j < 16; ++j) { const unsigned c = xb_ld(&bar[XB_XCNT(j)]); sum += c; cnt += (c > 0u) ? 1u : 0u; mine = (j == x) ? c : mine; }
        if (sum == G) break;
        __builtin_amdgcn_s_sleep(1);
        if ((++sp & 255u) == 0u) { if (xb_ld(&bar[XB_TMO])) break; if (sp > XB_SPIN_CAP) { atomicAdd(&bar[XB_TMO], 1u); break; } }
    }
    nloc = mine > 0u ? mine : 1u; nx = cnt > 0u ? cnt : 1u;
}
__device__ __forceinline__ void xcd_barrier(const XcdBarrier& b, const bool t0) {
    asm volatile("s_waitcnt vmcnt(0)" ::: "memory");
    __syncthreads();
    if (t0) {
        unsigned* bar = b.bar;
        __builtin_amdgcn_s_waitcnt(0);
        unsigned nloc = b.st[0], nx = b.st[1];
        if (nloc == 0u) { xcd_barrier_complete(bar, b.x, nloc, nx); b.st[0] = nloc; b.st[1] = nx; }
        const unsigned old = xb_add(&bar[XB_XSUB(b.x)], 1u);
        const unsigned gen = old / nloc;
        if (old + 1u == (gen + 1u) * nloc) {
            __builtin_amdgcn_fence(__ATOMIC_RELEASE, "agent");
            asm volatile("s_waitcnt vmcnt(0)" ::: "memory");
            const unsigned og = xb_add(&bar[XB_TOP], 1u);
            const unsigned tg = og / nx;
            if (og + 1u == (tg + 1u) * nx) xb_add(&bar[XB_TOPGEN], 1u);
            else XB_SPIN(xb_ld(&bar[XB_TOPGEN]) == tg, bar);
            __builtin_amdgcn_fence(__ATOMIC_ACQUIRE, "agent");
            xb_add(&bar[XB_XGEN(b.x)], 1u);
            asm volatile("s_waitcnt vmcnt(0)" ::: "memory");
        } else {
            XB_SPIN(xb_ld(&bar[XB_XGEN(b.x)]) == gen, bar);
            __builtin_amdgcn_fence(__ATOMIC_ACQUIRE, "agent");
            asm volatile("s_waitcnt vmcnt(0)" ::: "memory");
        }
    }
    __syncthreads();
}

#ifndef PHMASK
#define PHMASK 0xFFFF
#endif
#define PH(n) ((PHMASK >> (n)) & 1)
#define LQ() int lq = l; unsigned char* ws = P.ws; asm volatile("" : "+s"(lq)); asm volatile("" : "+s"(ws)); \
    bf16_t* Z = (bf16_t*)(ws + WS_Z); bf16_t* MG = (bf16_t*)(ws + WS_MG); float* gates = (float*)(ws + WS_GATES); float* hstat = (float*)(ws + WS_HSTAT); \
    bf16_t* XBc = (bf16_t*)(ws + ((lq & 1) ? WS_XB1 : WS_XB0)); bf16_t* XBn = (bf16_t*)(ws + ((lq & 1) ? WS_XB0 : WS_XB1)); \
    float* ssc = (float*)(ws + ((lq & 1) ? WS_SS1 : WS_SS0)); float* ssn = (float*)(ws + ((lq & 1) ? WS_SS0 : WS_SS1)); \
    const float* bin = P.b_in + (size_t)lq * NIN; \
    bf16_t* WYc = (bf16_t*)(ws + ((lq & 1) ? WS_WY1 : WS_WY)); bf16_t* WYn = (bf16_t*)(ws + ((lq & 1) ? WS_WY : WS_WY1)); \
    bf16_t* WGMc = (bf16_t*)(ws + ((lq & 1) ? WS_WGM1 : WS_WGM)); bf16_t* WGMn = (bf16_t*)(ws + ((lq & 1) ? WS_WGM : WS_WGM1)); \
    bf16_t* WGRc = (bf16_t*)(ws + ((lq & 1) ? WS_WGR1 : WS_WGR)); bf16_t* WGRn = (bf16_t*)(ws + ((lq & 1) ? WS_WGR : WS_WGR1)); \
    (void)Z; (void)MG; (void)gates; (void)hstat; (void)XBc; (void)XBn; (void)ssc; (void)ssn; (void)bin; (void)WYc; (void)WYn; (void)WGMc; (void)WGMn; (void)WGRc; (void)WGRn
#define OPQ() int tq = wave * 64 + lane_id_fresh(), vcuq = vcu, Gq = G; asm volatile("" : "+s"(vcuq), "+s"(Gq))
__global__ void __launch_bounds__(512, 2) fwd_megakernel(Params P) {
    extern __shared__ __attribute__((aligned(16))) unsigned char lds_raw[];
    LAS unsigned char* lds = (LAS unsigned char*)lds_raw;
    cg::grid_group grid = cg::this_grid();
    const int G = gridDim.x, bx = blockIdx.x;
    const int vcu = (G % 8 == 0) ? (bx % 8) * (G / 8) + bx / 8 : bx;
    const int wave = __builtin_amdgcn_readfirstlane((int)threadIdx.x >> 6);
    unsigned* barw = (unsigned*)(P.ws + WS_CTL);
    volatile LAS unsigned* bst = (volatile LAS unsigned*)(lds + LDS_BYTES - 64);
    { const int tid0 = threadIdx.x; if (bx == 0) for (int i = tid0; i < XCD_BAR_WORDS; i += 512) barw[i] = 0u;
      if (tid0 < 2) bst[tid0] = 0u; }
    XcdBarrier xbar; xbar.bar = barw; xbar.x = 0; xbar.st = bst;
    bool posted = false;
#define LANEID() ((int)__builtin_amdgcn_mbcnt_hi(~0u, __builtin_amdgcn_mbcnt_lo(~0u, 0u)))
#define GSYNC() do { const bool t0_ = (wave == 0) && (lane_id_fresh() == 0); if (!posted) { grid.sync(); xbar = xcd_barrier_post(barw, bst, t0_); posted = true; } else xcd_barrier(xbar, t0_); } while (0)
    { OPQ(); prep0_phase(P, vcuq, Gq, tq); }
    for (int l = 0; l < NLAYER; ++l) {
        if (l == 0) { { LQ(); OPQ(); prep_phase(P, 0, 0, WYc, WGMc, WGRc, lds, vcuq * 8, Gq * 8, tq); } GSYNC(); }
        if (PH(1)) {
            LQ();
            Sched<1> S; S.T.init(NTOK, 7168, G, bx);
            S.g0 = SubG{(const char*)XBc, (const char*)(ws + WS_W1), 2048u, 2048u, 16}; S.g1 = S.g0; S.g2 = S.g0; S.g3 = S.g0;
            EpiIn E{ssc, bin, Z, gates, (const float*)(ws + WS_ROPE)};
            { OPQ(); gemm_phase(lds, S, E, tq); }
        }
        GSYNC();
        if (PH(2)) { LQ(); OPQ(); prescan_phase(P, lq, MG, XBn, XBc, ssc, lds, vcuq, Gq, tq); pconv_phase(P, lq, vcuq * 8, Gq * 8, tq); }
        GSYNC();
        if (PH(2)) { LQ(); OPQ(); scan_phase(P, lq, MG, XBn, lds, vcuq, tq); }
        if (vcu >= 192) {   LQ();
            { OPQ(); prep_phase(P, lq, 1, WYn, WGMn, WGRn, lds, (vcuq - 192) * 8, 512, tq); }
            if (lq + 1 < NLAYER) { OPQ(); prep_phase(P, lq + 1, 0, WYn, WGMn, WGRn, lds, (vcuq - 192) * 8, 512, tq); }
            __syncthreads();
            Sched<1> S; S.T.init(NTOK, 1024, 64, vcu - 192);
            S.g0 = SubG{(const char*)XBc, (const char*)WGMc, 2048u, 2048u, 16}; S.g1 = S.g0; S.g2 = S.g0; S.g3 = S.g0;
            EpiMerge E{ssc, bin, Z, MG, 0};
            { OPQ(); gemm_phase(lds, S, E, tq); }
        }
        GSYNC();
        if (PH(3)) {
            LQ();
            Sched<1> S; S.T.init(NTOK, 3072, G, bx);
            S.g0 = SubG{(const char*)XBc, (const char*)WYc, 2048u, 2048u, 16}; S.g1 = S.g0; S.g2 = S.g0; S.g3 = S.g0;
            EpiY E{ssc, bin, Z, hstat, P.m_norm_g + lq * 1024, P.r_norm_g + lq * 2048};
            { OPQ(); gemm_phase(lds, S, E, tq); }
        }
        GSYNC();
        if (PH(4)) {
            LQ();
            Sched<3> S; S.T.init(NTOK, 1024, G, bx);
            S.g0 = SubG{(const char*)(Z + 2048), (const char*)(ws + WS_WBM), (unsigned)(ZW * 2), 2048u, 16};
            S.g1 = SubG{(const char*)XBc, (const char*)WGRc, 2048u, 2048u, 16};
            S.g2 = SubG{(const char*)(Z + 5120), (const char*)(ws + WS_WBR), (unsigned)(ZW * 2), 4096u, 32};
            S.g3 = S.g0;
            EpiMerge E{ssc, bin, Z, MG, 1};
            { OPQ(); gemm_phase(lds, S, E, tq); }
        }
        GSYNC();
        if (PH(5)) {
            LQ();
            Sched<1> S; S.T.init(NTOK, 1024, G, bx);
            S.g0 = SubG{(const char*)MG, (const char*)(ws + WS_WOUT), 2048u, 2048u, 16}; S.g1 = S.g0; S.g2 = S.g0; S.g3 = S.g0;
            EpiX E{XBc, XBc, ssc, nullptr};
            { OPQ(); gemm_phase(lds, S, E, tq); }
        }
        GSYNC();
        if (PH(6)) {
            LQ();
            Sched<1> S; S.T.init(NTOK, FF, G, bx);
            S.g0 = SubG{(const char*)XBc, (const char*)(ws + WS_WFF1), 2048u, 2048u, 16}; S.g1 = S.g0; S.g2 = S.g0; S.g3 = S.g0;
            EpiFF1 E{ssc, P.b_ff1 + (size_t)lq * FF, Z};
            { OPQ(); gemm_phase(lds, S, E, tq); }
        }
        GSYNC();
        if (PH(7)) {
            LQ();
            Sched<1> S; S.T.init(NTOK, 1024, G, bx);
            S.g0 = SubG{(const char*)Z, (const char*)(ws + WS_WFF2), 8192u, 8192u, 64}; S.g1 = S.g0; S.g2 = S.g0; S.g3 = S.g0;
            EpiX E{XBc, XBc, ssc, P.b_ff2 + (size_t)lq * DM};
            { OPQ(); gemm_phase(lds, S, E, tq); }
        }
        GSYNC();
        if (PH(8)) {
            LQ();
            Sched<2> S; S.T.init(NTOK, 1024, G, bx);
            S.g0 = SubG{(const char*)XBc, (const char*)(ws + WS_WPG), 2048u, 2048u, 16};
            S.g1 = SubG{(const char*)(ws + WS_PB), (const char*)(ws + WS_WPE), 512u, 512u, 4};
            S.g2 = S.g0; S.g3 = S.g0;
            EpiPE E{ssc, Z, XBc, XBn, ssn};
            { OPQ(); gemm_phase(lds, S, E, tq); }
        }
        GSYNC();
    }
    {
        unsigned char* ws = P.ws;
        const float* ss = (const float*)(ws + WS_SS0);
        const bf16_t* XBf = (const bf16_t*)(ws + WS_XB0);
        const int lane = lane_id_fresh();
        const int gw = vcu * 8 + wave, NGW = G * 8;
        for (int row = gw; row < NTOK; row += NGW) {
            float s = (lane < 16) ? ss[(size_t)row * 16 + lane] : 0.f;
#pragma unroll
            for (int o = 1; o < 64; o <<= 1) s += __shfl_xor(s, o);
            const float rs = rsqrtf(s * (1.f / DM) + EPS);
#pragma unroll
            for (int j = 0; j < 2; ++j) {
                const u32x4 w = *((const u32x4*)(XBf + (size_t)row * DM) + lane + 64 * j);
                f32x4 x0, x1; unpack8(w, x0, x1);
                const f32x4 g0 = *((const f32x4*)P.final_g + 2 * (lane + 64 * j)), g1 = *((const f32x4*)P.final_g + 2 * (lane + 64 * j) + 1);
                f32x4* o = (f32x4*)(P.out + (size_t)row * DM) + 2 * (lane + 64 * j);
                o[0] = x0 * rs * g0; o[1] = x1 * rs * g1;
            }
        }
    }
}

extern "C" void kernel_launch(void* const* d_in, const int* in_sizes, int n_in, void* d_out, int out_size, void* d_ws, size_t ws_size, hipStream_t stream) {
    static int grid = 0;
    if (grid == 0) {
        if (n_in != 21 || out_size != NTOK * DM || ws_size < WS_END) { fprintf(stderr, "kernel_launch: unexpected shapes / workspace (n_in %d out %d ws %zu)\n", n_in, out_size, ws_size); grid = -1; return; }
        int dev = 0, cus = 0, per_cu = 0;
        (void)hipGetDevice(&dev);
        (void)hipDeviceGetAttribute(&cus, hipDeviceAttributeMultiprocessorCount, dev);
        (void)hipFuncSetAttribute((const void*)fwd_megakernel, hipFuncAttributeMaxDynamicSharedMemorySize, LDS_BYTES);
        (void)hipOccupancyMaxActiveBlocksPerMultiprocessor(&per_cu, (const void*)fwd_megakernel, 512, LDS_BYTES);
        (void)hipGetLastError();
        if (per_cu < 1) per_cu = 1;
        grid = cus;
    }
    if (grid < 0) return;
    Params p{};
    const float** pp = (const float**)&p;
    for (int i = 0; i < 21; ++i) pp[i] = (const float*)d_in[i];
    p.out = (float*)d_out; p.ws = (unsigned char*)d_ws;
    void* args[] = {&p};
    hipError_t e = hipLaunchCooperativeKernel((const void*)fwd_megakernel, dim3(grid), dim3(512), args, LDS_BYTES, stream);
    if (e != hipSuccess) fprintf(stderr, "cooperative launch failed: %s (grid %d)\n", hipGetErrorString(e), grid);
}
```

```cpp
#include <hip/hip_runtime.h>
#include <hip/hip_cooperative_groups.h>
#include <cstdio>
#include <cstdint>
namespace cg = cooperative_groups;

#define LAS __attribute__((address_space(3)))
typedef unsigned short bf16_t;
typedef short bf16x8 __attribute__((ext_vector_type(8)));
typedef short s16x4 __attribute__((ext_vector_type(4)));
typedef float f32x4 __attribute__((ext_vector_type(4)));
typedef float f32x2 __attribute__((ext_vector_type(2)));
typedef unsigned u32x4 __attribute__((ext_vector_type(4)));
typedef unsigned u32x2 __attribute__((ext_vector_type(2)));

constexpr int XL_OFF = 131072, XL_SZ = 1280;
constexpr int NTOK = 32768, DM = 1024, SEQ = 8192, NLAYER = 4, NIN = 12296, ZW = 7168, FF = 4096, PED = 256;
constexpr float EPS = 1e-6f;
constexpr size_t MiB = 1u << 20;
constexpr size_t WS_W1 = 0, WS_WY = 15 * MiB, WS_WGM = 21 * MiB, WS_WGR = 23 * MiB, WS_WBM = 25 * MiB, WS_WBR = 27 * MiB, WS_WOUT = 31 * MiB,
                 WS_WFF1 = 33 * MiB, WS_WFF2 = 41 * MiB, WS_WPG = 49 * MiB, WS_WPE = 51 * MiB, WS_PB = 52 * MiB, WS_XB0 = 68 * MiB, WS_XB1 = 132 * MiB,
                 WS_MG = 196 * MiB, WS_GATES = 260 * MiB, WS_SS0 = 261 * MiB, WS_SS1 = 263 * MiB, WS_HSTAT = 265 * MiB, WS_ROPE = 281 * MiB, WS_Z = 289 * MiB,
                 WS_GV = 737 * MiB, WS_CTL = 739 * MiB, WS_WY1 = 740 * MiB, WS_WGM1 = 746 * MiB, WS_WGR1 = 748 * MiB, WS_END = 750 * MiB;
constexpr int LDS_BYTES = 155648;

struct Params {
    const float *x, *p, *norm1_g, *w_in, *b_in, *conv_w, *conv_b, *m_norm_g, *r_norm_g, *w_bm, *w_br, *w_out, *norm2_g, *w_ff1, *b_ff1, *w_ff2, *b_ff2,
        *norm3_g, *w_pe_gate, *w_pe, *final_g;
    float* out; unsigned char* ws;
};

__device__ __forceinline__ int lane_id_fresh() { unsigned z = 0u; asm volatile("" : "+v"(z)); return (int)__builtin_amdgcn_mbcnt_hi(~0u, __builtin_amdgcn_mbcnt_lo(~0u, z)); }
__device__ __forceinline__ unsigned cvt_pk_bf16(float lo, float hi) { unsigned r; asm volatile("v_cvt_pk_bf16_f32 %0, %1, %2" : "=v"(r) : "v"(lo), "v"(hi)); return r; }
__device__ __forceinline__ float bflo(unsigned u) { return __uint_as_float(u << 16); }
__device__ __forceinline__ float bfhi(unsigned u) { return __uint_as_float(u & 0xffff0000u); }
__device__ __forceinline__ float fma_s(float a, float b, float c) { float r; asm volatile("v_fma_f32 %0, %1, %2, %3" : "=v"(r) : "v"(a), "v"(b), "v"(c)); return r; }
__device__ __forceinline__ float mul_s(float a, float b) { float r; asm volatile("v_mul_f32_e32 %0, %1, %2" : "=v"(r) : "v"(a), "v"(b)); return r; }
__device__ __forceinline__ float add_s(float a, float b) { float r; asm volatile("v_add_f32_e32 %0, %1, %2" : "=v"(r) : "v"(a), "v"(b)); return r; }
__device__ __forceinline__ float sub_s(float a, float b) { float r; asm volatile("v_sub_f32_e32 %0, %1, %2" : "=v"(r) : "v"(a), "v"(b)); return r; }
__device__ __forceinline__ float relu_s(float a) { float r; asm volatile("v_max_f32_e32 %0, 0, %1" : "=v"(r) : "v"(a)); return r; }
__device__ __forceinline__ f32x4 fma4s(f32x4 a, float s, f32x4 c) { return (f32x4){fma_s(a[0], s, c[0]), fma_s(a[1], s, c[1]), fma_s(a[2], s, c[2]), fma_s(a[3], s, c[3])}; }
__device__ __forceinline__ f32x4 fma4(f32x4 a, f32x4 b, f32x4 c) { return (f32x4){fma_s(a[0], b[0], c[0]), fma_s(a[1], b[1], c[1]), fma_s(a[2], b[2], c[2]), fma_s(a[3], b[3], c[3])}; }
__device__ __forceinline__ f32x4 mul4(f32x4 a, f32x4 b) { return (f32x4){mul_s(a[0], b[0]), mul_s(a[1], b[1]), mul_s(a[2], b[2]), mul_s(a[3], b[3])}; }
__device__ __forceinline__ f32x4 mul4s(f32x4 a, float s) { return (f32x4){mul_s(a[0], s), mul_s(a[1], s), mul_s(a[2], s), mul_s(a[3], s)}; }
__device__ __forceinline__ f32x4 add4(f32x4 a, f32x4 b) { return (f32x4){add_s(a[0], b[0]), add_s(a[1], b[1]), add_s(a[2], b[2]), add_s(a[3], b[3])}; }
__device__ __forceinline__ f32x4 sub4s(f32x4 a, float s) { return (f32x4){sub_s(a[0], s), sub_s(a[1], s), sub_s(a[2], s), sub_s(a[3], s)}; }
__device__ __forceinline__ f32x4 relu4(f32x4 a) { return (f32x4){relu_s(a[0]), relu_s(a[1]), relu_s(a[2]), relu_s(a[3])}; }
__device__ __forceinline__ float sigmoidf_(float v) { float r = __builtin_amdgcn_rcpf(1.f + __expf(-v)); asm volatile("s_nop 1" : "+v"(r)); return r; }
__device__ __forceinline__ f32x4 sigmoid4(f32x4 v) { return (f32x4){sigmoidf_(v[0]), sigmoidf_(v[1]), sigmoidf_(v[2]), sigmoidf_(v[3])}; }
__device__ __forceinline__ u32x2 pack4(f32x4 v) { u32x2 w; w.x = cvt_pk_bf16(v[0], v[1]); w.y = cvt_pk_bf16(v[2], v[3]); return w; }
__device__ __forceinline__ u32x4 pack8(f32x4 a, f32x4 b) { u32x4 w; w.x = cvt_pk_bf16(a[0], a[1]); w.y = cvt_pk_bf16(a[2], a[3]); w.z = cvt_pk_bf16(b[0], b[1]); w.w = cvt_pk_bf16(b[2], b[3]); return w; }
#define LDS_WAIT() asm volatile("s_waitcnt lgkmcnt(0)" ::: "memory")

constexpr int BM = 256, BK = 64, HALF = 128, HTB = HALF * BK * 2, STAGE_BYTES = 8 * HTB, NXCD = 8, WGM = 8;
__device__ __forceinline__ int lds_byte(int r, int c) { const int st = (r >> 4) * 2 + (c >> 5), rr = r & 15, cc = c & 31, ob = rr * 64 + cc * 2; return st * 1024 + (ob ^ (((ob >> 9) & 1) << 5)); }
__device__ __forceinline__ int perm32(int rho) { const int n = rho >> 4, i = rho & 15; return 8 * (i >> 2) + 4 * n + (i & 3); }
__device__ __forceinline__ void stage_rc(int b, int& R, int& C) { const int st = b / 1024, sb = b % 1024, swz = sb ^ (((sb >> 9) & 1) << 5); R = (st >> 1) * 16 + swz / 64; C = (st & 1) * 32 + (swz % 64) / 2; }

struct UnitD { const char* A; const char* B; unsigned lda, ldb; int nt, pm, pn, sub; };
struct SubG { const char* A; const char* B; unsigned lda, ldb; int nt; };
struct TileOrder {
    int nM, nN, nwg, G, c;
    __device__ void init(int M, int N, int G_, int c_) { nM = M / BM; nN = N / BM; nwg = nM * nN; G = G_; c = c_; }
    __device__ bool tile(int i, int& pm, int& pn) const {
        const long L = (long)i * G + c; if (L >= nwg) return false;
        int wgid = (int)L; { const int q = nwg / NXCD, r = nwg % NXCD, xcd = wgid % NXCD, off = wgid / NXCD; wgid = (xcd < r ? xcd * (q + 1) : r * (q + 1) + (xcd - r) * q) + off; }
        const int nig = WGM * nN, gid = wgid / nig, fm = gid * WGM, gsz = (nM - fm) < WGM ? (nM - fm) : WGM;
        pm = fm + ((wgid % nig) % gsz); pn = (wgid % nig) / gsz; return true;
    }
};
template <int NSUB> struct Sched {
    TileOrder T; SubG g0, g1, g2, g3;
    __device__ __forceinline__ bool next(int ui, UnitD& u) const {
        const int round = ui / NSUB, sub = ui % NSUB; int pm, pn;
        if (!T.tile(round, pm, pn)) return false;
        const char* gA = g0.A; const char* gB = g0.B; unsigned glda = g0.lda, gldb = g0.ldb; int gnt = g0.nt;
        if (NSUB > 1) { const bool s1 = sub == 1; gA = s1 ? g1.A : gA; gB = s1 ? g1.B : gB; glda = s1 ? g1.lda : glda; gldb = s1 ? g1.ldb : gldb; gnt = s1 ? g1.nt : gnt; }
        if (NSUB > 2) { const bool s2 = sub == 2; gA = s2 ? g2.A : gA; gB = s2 ? g2.B : gB; glda = s2 ? g2.lda : glda; gldb = s2 ? g2.ldb : gldb; gnt = s2 ? g2.nt : gnt; }
        if (NSUB > 3) { const bool s3 = sub == 3; gA = s3 ? g3.A : gA; gB = s3 ? g3.B : gB; glda = s3 ? g3.lda : glda; gldb = s3 ? g3.ldb : gldb; gnt = s3 ? g3.nt : gnt; }
        u.A = gA + (size_t)pm * BM * glda; u.B = gB + (size_t)pn * BM * gldb; u.lda = glda; u.ldb = gldb; u.nt = gnt; u.pm = pm; u.pn = pn; u.sub = sub; return true;
    }
};

template <class Epi, class SchedT>
__device__ __forceinline__ void gemm_phase(LAS unsigned char* lds, const SchedT& S, const Epi& E, const int tid) {
    const int wid = __builtin_amdgcn_readfirstlane(tid >> 6), lane = tid & 63, wr = wid >> 2, wc = wid & 3, fr = lane & 15, fq = lane >> 4;
    int sR0, sC0, sR1, sC1; stage_rc(tid * 16, sR0, sC0); stage_rc(tid * 16 + 8192, sR1, sC1);
    UnitD cur, nxt; int ui = 0;
    if (!S.next(0, cur)) return;
    LAS float* xl = (LAS float*)(lds + XL_OFF);
#define PRE_TID() (wid * 64 + lane_id_fresh())
    E.pre(cur, PRE_TID(), xl);
    const unsigned sRr[2] = {(unsigned)sR0, (unsigned)sR1}, sCc[2] = {(unsigned)sC0 * 2u, (unsigned)sC1 * 2u};
    const unsigned sRb[2] = {(unsigned)((sR0 & ~31) + perm32(sR0 & 31)), (unsigned)((sR1 & ~31) + perm32(sR1 & 31))};
    const size_t kstep = (size_t)(BK * 2);
    const unsigned ldsw = (unsigned)wid * 1024u;
    const int aoff = lds_byte(wr * 64 + fr, fq * 8), boff = lds_byte(wc * 32 + fr, fq * 8);
#define PG8_SA(b, h) (((b) * 2 + (h)) * HTB)
#define PG8_SB(b, h) ((4 + (b) * 2 + (h)) * HTB)
#define PG8_STAGE_(bufoff, gbase, ld, RR) do { _Pragma("unroll") for (int _i = 0; _i < 2; ++_i) \
        __builtin_amdgcn_global_load_lds((const unsigned*)((const char*)(gbase) + (RR[_i] * (ld) + sCc[_i])), (LAS unsigned*)(lds + (bufoff) + ldsw + _i * 8192), 16, 0, 0); } while (0)
#define PG8_STAGE(bufoff, gbase, ld) PG8_STAGE_(bufoff, gbase, ld, sRr)
#define PG8_STAGEB(bufoff, gbase, ld) PG8_STAGE_(bufoff, gbase, ld, sRb)
#define PG8_LDA(dst, b, h) do { _Pragma("unroll") for (int m = 0; m < 4; ++m) _Pragma("unroll") for (int k = 0; k < 2; ++k) dst[m][k] = *(const LAS bf16x8*)(lds + PG8_SA(b, h) + aoff + m * 2048 + k * 1024); } while (0)
#define PG8_LDB(dst, b, h) do { _Pragma("unroll") for (int n = 0; n < 2; ++n) _Pragma("unroll") for (int k = 0; k < 2; ++k) dst[n][k] = *(const LAS bf16x8*)(lds + PG8_SB(b, h) + boff + n * 2048 + k * 1024); } while (0)
#define PG8_MMA(ai, bj, At, Bt) do { __builtin_amdgcn_s_setprio(1); _Pragma("unroll") for (int m = 0; m < 4; ++m) _Pragma("unroll") for (int n = 0; n < 2; ++n) _Pragma("unroll") for (int k = 0; k < 2; ++k) \
        acc[ai][bj][m][n] = __builtin_amdgcn_mfma_f32_16x16x32_bf16(Bt[n][k], At[m][k], acc[ai][bj][m][n], 0, 0, 0); __builtin_amdgcn_s_setprio(0); } while (0)
#define PG8_WAIT_V(n) asm volatile("s_waitcnt vmcnt(" #n ")" ::: "memory")
#define PG8_WAIT_L(n) asm volatile("s_waitcnt lgkmcnt(" #n ")" ::: "memory")
#define PG8_WAIT_VX() PG8_WAIT_V(8)
#define PG8_BAR __builtin_amdgcn_s_barrier()
#define PG8_SCHED __builtin_amdgcn_sched_barrier(0)
    f32x4 acc[2][2][4][2];
#pragma unroll
    for (int a = 0; a < 2; ++a)
#pragma unroll
        for (int b = 0; b < 2; ++b)
#pragma unroll
            for (int m = 0; m < 4; ++m)
#pragma unroll
                for (int n = 0; n < 2; ++n) acc[a][b][m][n] = (f32x4){0.f, 0.f, 0.f, 0.f};
    bf16x8 At[4][2], B0[2][2], B1[2][2];
    const char* cA = cur.A; const char* cB = cur.B;
    {
        const size_t hA = (size_t)HALF * cur.lda, hB = (size_t)HALF * cur.ldb;
        PG8_STAGEB(PG8_SB(0, 0), cB, cur.ldb); PG8_STAGEB(PG8_SB(0, 1), cB + hB, cur.ldb); PG8_STAGE(PG8_SA(0, 0), cA, cur.lda); PG8_STAGE(PG8_SA(0, 1), cA + hA, cur.lda);
        if (wr == 1) PG8_BAR;
        PG8_WAIT_V(2); PG8_BAR;
        PG8_STAGEB(PG8_SB(1, 0), cB + kstep, cur.ldb); PG8_STAGE(PG8_SA(1, 0), cA + kstep, cur.lda); PG8_STAGEB(PG8_SB(1, 1), cB + hB + kstep, cur.ldb);
        PG8_WAIT_V(6); PG8_BAR;
    }
    for (;;) {
        const bool has_next = S.next(ui + 1, nxt);
        const char* nA = has_next ? nxt.A : cA; const char* nB = has_next ? nxt.B : cB;
        const unsigned nlda = has_next ? nxt.lda : cur.lda, nldb = has_next ? nxt.ldb : cur.ldb;
        const size_t hA = (size_t)HALF * cur.lda, hB = (size_t)HALF * cur.ldb, nhA = (size_t)HALF * nlda, nhB = (size_t)HALF * nldb;
        const int nt = cur.nt;
        for (int t = 0; t < nt; t += 2) {
            const bool last = (t == nt - 2);
            const char* a1 = cA + (size_t)(t + 1) * kstep;
            const char* a2 = last ? nA : cA + (size_t)(t + 2) * kstep; const char* b2 = last ? nB : cB + (size_t)(t + 2) * kstep;
            const char* a3 = a2 + kstep; const char* b3 = b2 + kstep;
            const unsigned la2 = last ? nlda : cur.lda, lb2 = last ? nldb : cur.ldb;
            const size_t ha2 = last ? nhA : hA, hb2 = last ? nhB : hB;
            PG8_LDB(B0, 0, 0); PG8_LDB(B1, 0, 1); PG8_SCHED; PG8_LDA(At, 0, 0); PG8_STAGE(PG8_SA(1, 1), a1 + hA, cur.lda);
            PG8_WAIT_VX(); PG8_WAIT_L(0); PG8_BAR; PG8_MMA(0, 0, At, B0); PG8_MMA(0, 1, At, B1); PG8_BAR; PG8_SCHED;
            PG8_LDA(At, 0, 1); PG8_STAGEB(PG8_SB(0, 0), b2, lb2); PG8_STAGEB(PG8_SB(0, 1), b2 + hb2, lb2); PG8_STAGE(PG8_SA(0, 0), a2, la2);
            PG8_WAIT_VX(); PG8_WAIT_L(0); PG8_BAR; PG8_MMA(1, 0, At, B0); PG8_MMA(1, 1, At, B1); PG8_BAR; PG8_SCHED;
            PG8_LDB(B0, 1, 0); PG8_LDB(B1, 1, 1); PG8_SCHED; PG8_LDA(At, 1, 0); PG8_STAGE(PG8_SA(0, 1), a2 + ha2, la2);
            PG8_WAIT_VX(); PG8_WAIT_L(0); PG8_BAR; PG8_MMA(0, 0, At, B0); PG8_MMA(0, 1, At, B1); PG8_BAR; PG8_SCHED;
            PG8_LDA(At, 1, 1); PG8_STAGEB(PG8_SB(1, 0), b3, lb2); PG8_STAGEB(PG8_SB(1, 1), b3 + hb2, lb2); PG8_STAGE(PG8_SA(1, 0), a3, la2);
            PG8_WAIT_V(8); PG8_WAIT_L(0); PG8_BAR; PG8_MMA(1, 0, At, B0); PG8_MMA(1, 1, At, B1); PG8_BAR; PG8_SCHED;
        }
        if (wr == 0) PG8_BAR;
        asm volatile("s_nop 15\n\ts_nop 7" ::: "memory");
        (void)E(acc, cur, wr, wc, fr, fq, xl + (ui & 1) * XL_SZ);
        if (has_next) E.pre(nxt, PRE_TID(), xl + ((ui + 1) & 1) * XL_SZ);
        if (!has_next) break;
#pragma unroll
        for (int a = 0; a < 2; ++a)
#pragma unroll
            for (int b = 0; b < 2; ++b)
#pragma unroll
                for (int m = 0; m < 4; ++m)
#pragma unroll
                    for (int n = 0; n < 2; ++n) acc[a][b][m][n] = (f32x4){0.f, 0.f, 0.f, 0.f};
        cur = nxt; cA = nA; cB = nB; ++ui;
        if (wr == 1) PG8_BAR;
    }
    PG8_WAIT_V(0);
    PG8_BAR;
#undef PG8_SA
#undef PG8_SB
#undef PG8_STAGE
#undef PG8_STAGEB
#undef PG8_STAGE_
#undef PG8_LDA
#undef PG8_LDB
#undef PG8_MMA
#undef PG8_WAIT_V
#undef PG8_WAIT_L
#undef PG8_WAIT_VX
#undef PG8_BAR
#undef PG8_SCHED
}

typedef f32x4 AccT[2][2][4][2];
#define ROW(ai, m) (u.pm * BM + (ai) * HALF + wr * 64 + (m) * 16 + fr)
#define COL(bj, n) (u.pn * BM + (bj) * HALF + wc * 32 + fq * 8 + (n) * 4)
#define FOR_AI _Pragma("unroll") for (int ai = 0; ai < 2; ++ai)
#define FOR_M _Pragma("unroll") for (int m = 0; m < 4; ++m)
#define FOR_BJ _Pragma("unroll") for (int bj = 0; bj < 2; ++bj)
#define FOR_N _Pragma("unroll") for (int n = 0; n < 2; ++n)
__device__ __forceinline__ void rows_rstd(const float* ss, const UnitD& u, int wr, int fr, int fq, float (&rs)[2][4]) {
    f32x4 v[2][4];
    FOR_AI FOR_M v[ai][m] = *(const f32x4*)(ss + (size_t)ROW(ai, m) * 16 + fq * 4);
    float t[2][4], e[2][4];
    FOR_AI FOR_M t[ai][m] = (v[ai][m][0] + v[ai][m][1]) + (v[ai][m][2] + v[ai][m][3]);
    FOR_AI FOR_M e[ai][m] = __shfl_xor(t[ai][m], 16);
    FOR_AI FOR_M t[ai][m] += e[ai][m];
    FOR_AI FOR_M e[ai][m] = __shfl_xor(t[ai][m], 32);
    FOR_AI FOR_M rs[ai][m] = rsqrtf((t[ai][m] + e[ai][m]) * (1.f / DM) + EPS);
}

__device__ __forceinline__ void pre_rstd(const float* ss, const UnitD& nu, int tid, LAS float* xb) {
    const float* sp = ss + (size_t)(nu.pm * BM + (tid >> 1)) * 16 + (tid & 1) * 8;
    const f32x4 t = *(const f32x4*)sp + *(const f32x4*)(sp + 4);
    float s = (t[0] + t[1]) + (t[2] + t[3]);
    s += __shfl_xor(s, 1);
    if ((tid & 1) == 0) xb[tid >> 1] = rsqrtf(s * (1.f / DM) + EPS);
}
__device__ __forceinline__ void pre_vec(const float* src, int tid, LAS float* dst) { if (tid < 64) *(LAS f32x4*)(dst + tid * 4) = *(const f32x4*)(src + tid * 4); }
#define XB_RS(ai, m) xb[(ai) * HALF + wr * 64 + (m) * 16 + fr]
#define XB_MU(ai, m) xb[256 + (ai) * HALF + wr * 64 + (m) * 16 + fr]
#define XB_HR(ai, m) xb[512 + (ai) * HALF + wr * 64 + (m) * 16 + fr]
#define XB_BI(bj, n) (*(const LAS f32x4*)(xb + 768 + (bj) * HALF + wc * 32 + fq * 8 + (n) * 4))
#define XB_GN(bj, n) (*(const LAS f32x4*)(xb + 1024 + (bj) * HALF + wc * 32 + fq * 8 + (n) * 4))

__device__ __forceinline__ void unpack8(const u32x4 w, f32x4& a, f32x4& b) { a = (f32x4){bflo(w.x), bfhi(w.x), bflo(w.y), bfhi(w.y)}; b = (f32x4){bflo(w.z), bfhi(w.z), bflo(w.w), bfhi(w.w)}; }
template <bool BIAS, bool GATED>
__device__ __forceinline__ int x_update(const AccT& acc, const UnitD& u, int wr, int wc, int fr, int fq, const bf16_t* xin, bf16_t* xout, float* ss, const float* bias, const bf16_t* gate) {
    f32x4 bv[2][2];
    FOR_BJ FOR_N bv[bj][n] = BIAS ? *(const f32x4*)(bias + COL(bj, n)) : (f32x4){0.f, 0.f, 0.f, 0.f};
    FOR_AI {
#pragma unroll
      for (int mh = 0; mh < 2; ++mh) {
        u32x4 xv[4][2], gv[4][2];
#pragma unroll
        for (int m = mh * 2; m < mh * 2 + 2; ++m) FOR_BJ {
            const size_t o = (size_t)ROW(ai, m) * DM + COL(bj, 0);
            xv[m][bj] = *(const u32x4*)(xin + o);
            if (GATED) gv[m][bj] = *(const u32x4*)(gate + o);
        }
#pragma unroll
        for (int m = mh * 2; m < mh * 2 + 2; ++m) {
            const int row = ROW(ai, m);
            float part = 0.f;
            FOR_BJ {
                f32x4 x0, x1; unpack8(xv[m][bj], x0, x1);
                f32x4 a0 = acc[ai][bj][m][0], a1 = acc[ai][bj][m][1];
                f32x4 r0, r1;
                if (GATED) { f32x4 g0, g1; unpack8(gv[m][bj], g0, g1); r0 = fma4(a0, g0, x0); r1 = fma4(a1, g1, x1); }
                else { r0 = add4(x0, a0); r1 = add4(x1, a1); }
                if (BIAS) { r0 = add4(r0, bv[bj][0]); r1 = add4(r1, bv[bj][1]); }
#pragma unroll
                for (int e = 0; e < 4; ++e) { part = fma_s(r0[e], r0[e], part); part = fma_s(r1[e], r1[e], part); }
                *(u32x4*)(xout + (size_t)row * DM + COL(bj, 0)) = pack8(r0, r1);
            }
            part += __shfl_xor(part, 16); part += __shfl_xor(part, 32);
            if (fq == 0) ss[(size_t)row * 16 + u.pn * 4 + wc] = part;
        }
        asm volatile("" ::: "memory");
      }
    }
    return 16;
}

struct EpiIn {
    const float* ss; const float* bin; bf16_t* Z; float* gates; const float* ropec;
    __device__ __forceinline__ void pre(const UnitD& nu, int tid, LAS float* xb) const {
        pre_rstd(ss, nu, tid, xb);
        if (tid < 64) { const int c = tid * 4, col = nu.pn * BM + c;
            const f32x4 b = (nu.pn < 28) ? *(const f32x4*)(bin + (col < 3072 ? col : col + 1032)) : (c < 8 ? *(const f32x4*)(bin + 4096 + c) : (f32x4){0.f, 0.f, 0.f, 0.f});
            *(LAS f32x4*)(xb + 768 + c) = b; }
    }
    __device__ __forceinline__ int operator()(const AccT& acc, const UnitD& u, int wr, int wc, int fr, int fq, const LAS float* xb) const {
        f32x4 bv[2][2];
        FOR_BJ FOR_N bv[bj][n] = XB_BI(bj, n);
        float rs[2][4];
        FOR_AI FOR_M rs[ai][m] = XB_RS(ai, m);
        if (u.pn < 28) {
            if (u.pn >= 12 && u.pn < 20) {
                const float sc = u.pn >= 16 ? 0.0625f : 1.f;
                const float* ropes = ropec + (size_t)SEQ * 128;
                FOR_AI {
#pragma unroll
                    for (int mh = 0; mh < 2; ++mh) {
                        f32x4 cv[2][2], sv[2][2];
#pragma unroll
                        for (int mm = 0; mm < 2; ++mm) FOR_N { const size_t o = (size_t)(ROW(ai, mh * 2 + mm) & (SEQ - 1)) * 128 + wc * 32 + fq * 8 + n * 4; cv[mm][n] = *(const f32x4*)(ropec + o); sv[mm][n] = *(const f32x4*)(ropes + o); }
#pragma unroll
                        for (int mm = 0; mm < 2; ++mm) {
                            const int m = mh * 2 + mm;
                            f32x4 o1[2], o2[2];
                            FOR_N {
                                const f32x4 x1 = mul4s(fma4s(acc[ai][0][m][n], rs[ai][m], bv[0][n]), sc), x2 = mul4s(fma4s(acc[ai][1][m][n], rs[ai][m], bv[1][n]), sc);
#pragma unroll
                                for (int e = 0; e < 4; ++e) { o1[n][e] = fma_s(x1[e], cv[mm][n][e], -mul_s(x2[e], sv[mm][n][e])); o2[n][e] = fma_s(x1[e], sv[mm][n][e], mul_s(x2[e], cv[mm][n][e])); }
                            }
                            bf16_t* zr = Z + (size_t)ROW(ai, m) * ZW;
                            *(u32x4*)(zr + COL(0, 0)) = pack8(o1[0], o1[1]);
                            *(u32x4*)(zr + COL(1, 0)) = pack8(o2[0], o2[1]);
                        }
                        asm volatile("" ::: "memory");
                    }
                }
            } else {
                FOR_AI FOR_M FOR_BJ *(u32x4*)(Z + (size_t)ROW(ai, m) * ZW + COL(bj, 0)) = pack8(fma4s(acc[ai][bj][m][0], rs[ai][m], bv[bj][0]), fma4s(acc[ai][bj][m][1], rs[ai][m], bv[bj][1]));
            }
            return 16;
        } else {
            const f32x4 b0 = bv[0][0], b1 = bv[0][1];
            if (wc == 0 && fq == 0) { FOR_AI FOR_M { float* gp = gates + (size_t)ROW(ai, m) * 8; *(f32x4*)gp = fma4s(acc[ai][0][m][0], rs[ai][m], b0); *(f32x4*)(gp + 4) = fma4s(acc[ai][0][m][1], rs[ai][m], b1); } }
            return 0;
        }
    }
};
struct EpiY {
    const float* ss; const float* bin; bf16_t* Z; const float* hstat; const float* mg; const float* rg;
    __device__ __forceinline__ void pre(const UnitD& nu, int tid, LAS float* xb) const {
        pre_rstd(ss, nu, tid, xb);
        const bool isM = nu.pn < 4; const int hidx = isM ? nu.pn : 4 + ((nu.pn - 4) >> 1);
        const float invw = __builtin_bit_cast(float, __builtin_amdgcn_readfirstlane(isM ? 0x3b800000 : 0x3b000000));
        const float* hp = hstat + ((size_t)(nu.pm * BM + (tid >> 1)) * 8 + hidx) * 16 + (tid & 1) * 8;
        f32x4 t = (f32x4){0.f, 0.f, 0.f, 0.f};
        if (!(isM && (tid & 1))) t = *(const f32x4*)hp + *(const f32x4*)(hp + 4);
        float sm = t[0] + t[2], q = t[1] + t[3];
        sm += __shfl_xor(sm, 1); q += __shfl_xor(q, 1);
        if ((tid & 1) == 0) { const float mu = sm * invw; xb[256 + (tid >> 1)] = mu; xb[512 + (tid >> 1)] = rsqrtf(fmaxf(q * invw - mu * mu, 0.f) + EPS); }
        pre_vec(bin + (isM ? 3072 : 7176) + nu.pn * BM, tid, xb + 768);
        pre_vec((isM ? mg : rg - 1024) + nu.pn * BM, tid, xb + 1024);
    }
    __device__ __forceinline__ int operator()(const AccT& acc, const UnitD& u, int wr, int wc, int fr, int fq, const LAS float* xb) const {
        const bool isM = u.pn < 4;
        FOR_AI {
            float rs[4], mu[4], hr[4];
            FOR_M { rs[m] = XB_RS(ai, m); mu[m] = XB_MU(ai, m); hr[m] = XB_HR(ai, m); }
            FOR_M {
                u32x4 hv[2];
                FOR_BJ { const int col = COL(bj, 0); hv[bj] = *(const u32x4*)(Z + (size_t)ROW(ai, m) * ZW + (isM ? 2048 + col : col + 4096)); }
                FOR_BJ {
                    const int col = COL(bj, 0);
                    const u32x4 w = hv[bj];
                    f32x4 hh[2];
                    FOR_N {
                        const f32x4 g = fma4s(acc[ai][bj][m][n], rs[m], XB_BI(bj, n));
                        f32x4 gate = sigmoid4(g);
                        if (!isM) gate = mul4(gate, g);
                        const unsigned w0 = n ? w.z : w.x, w1 = n ? w.w : w.y;
                        const f32x4 h = (f32x4){bflo(w0), bfhi(w0), bflo(w1), bfhi(w1)};
                        hh[n] = mul4(mul4(mul4s(sub4s(h, mu[m]), hr[m]), XB_GN(bj, n)), gate);
                    }
                    *(u32x4*)(Z + (size_t)ROW(ai, m) * ZW + (isM ? 2048 + col : col + 4096)) = pack8(hh[0], hh[1]);
                }
                asm volatile("" ::: "memory");
            }
        }
        return 16;
    }
};
struct EpiMerge {
    const float* ss; const float* bin; bf16_t* Z; bf16_t* MG; int sub0;
    __device__ __forceinline__ void pre(const UnitD& nu, int tid, LAS float* xb) const {
        const int sub = nu.sub + sub0;
        if (sub == 0 || sub == 2) { pre_rstd(ss, nu, tid, xb); pre_vec(bin + (sub == 0 ? 10248 : 11272) + nu.pn * BM, tid, xb + 768); }
    }
    __device__ __forceinline__ int operator()(const AccT& acc, const UnitD& u, int wr, int wc, int fr, int fq, const LAS float* xb) const {
        const int sub = u.sub + sub0;
        if (sub == 0 || sub == 2) {
            const int toff = (sub == 0) ? 0 : 1024;
            f32x4 bv[2][2];
            FOR_BJ FOR_N bv[bj][n] = XB_BI(bj, n);
            float rs[2][4];
            FOR_AI FOR_M rs[ai][m] = XB_RS(ai, m);
            FOR_AI FOR_M FOR_BJ *(u32x4*)(Z + (size_t)ROW(ai, m) * ZW + toff + COL(bj, 0)) = pack8(sigmoid4(fma4s(acc[ai][bj][m][0], rs[ai][m], bv[bj][0])), sigmoid4(fma4s(acc[ai][bj][m][1], rs[ai][m], bv[bj][1])));
        } else if (sub == 1) {
            FOR_AI {
#pragma unroll
                for (int mh = 0; mh < 2; ++mh) {
                    u32x4 tv[2][2];
#pragma unroll
                    for (int mm = 0; mm < 2; ++mm) FOR_BJ tv[mm][bj] = *(const u32x4*)(Z + (size_t)ROW(ai, mh * 2 + mm) * ZW + COL(bj, 0));
#pragma unroll
                    for (int mm = 0; mm < 2; ++mm) FOR_BJ { const int m = mh * 2 + mm; f32x4 t0, t1; unpack8(tv[mm][bj], t0, t1); *(u32x4*)(Z + (size_t)ROW(ai, m) * ZW + COL(bj, 0)) = pack8(mul4(t0, acc[ai][bj][m][0]), mul4(t1, acc[ai][bj][m][1])); }
                    asm volatile("" ::: "memory");
                }
            }
        } else {
            FOR_AI {
#pragma unroll
                for (int mh = 0; mh < 2; ++mh) {
                    u32x4 ta[2][2], tb[2][2];
#pragma unroll
                    for (int mm = 0; mm < 2; ++mm) FOR_BJ { const bf16_t* zr = Z + (size_t)ROW(ai, mh * 2 + mm) * ZW + COL(bj, 0); ta[mm][bj] = *(const u32x4*)zr; tb[mm][bj] = *(const u32x4*)(zr + 1024); }
#pragma unroll
                    for (int mm = 0; mm < 2; ++mm) FOR_BJ {
                        const int m = mh * 2 + mm;
                        f32x4 a0, a1, b0, b1; unpack8(ta[mm][bj], a0, a1); unpack8(tb[mm][bj], b0, b1);
                        *(u32x4*)(MG + (size_t)ROW(ai, m) * DM + COL(bj, 0)) = pack8(fma4(b0, acc[ai][bj][m][0], a0), fma4(b1, acc[ai][bj][m][1], a1));
                    }
                    asm volatile("" ::: "memory");
                }
            }
        }
        return 16;
    }
};
struct EpiX {
    const bf16_t* xin; bf16_t* xout; float* ss; const float* bias;
    __device__ __forceinline__ void pre(const UnitD&, int, LAS float*) const {}
    __device__ __forceinline__ int operator()(const AccT& acc, const UnitD& u, int wr, int wc, int fr, int fq, const LAS float* xb) const {
        if (bias) return x_update<true, false>(acc, u, wr, wc, fr, fq, xin, xout, ss, bias, nullptr);
        return x_update<false, false>(acc, u, wr, wc, fr, fq, xin, xout, ss, nullptr, nullptr);
    }
};
struct EpiFF1 {
    const float* ss; const float* b1; bf16_t* H;
    __device__ __forceinline__ void pre(const UnitD& nu, int tid, LAS float* xb) const { pre_rstd(ss, nu, tid, xb); pre_vec(b1 + nu.pn * BM, tid, xb + 768); }
    __device__ __forceinline__ int operator()(const AccT& acc, const UnitD& u, int wr, int wc, int fr, int fq, const LAS float* xb) const {
        f32x4 bv[2][2];
        FOR_BJ FOR_N bv[bj][n] = XB_BI(bj, n);
        float rs[2][4];
        FOR_AI FOR_M rs[ai][m] = XB_RS(ai, m);
        FOR_AI FOR_M FOR_BJ {
            f32x4 vv[2];
            FOR_N {
                const f32x4 v = relu4(fma4s(acc[ai][bj][m][n], rs[ai][m], bv[bj][n]));
                vv[n] = mul4(v, v);
            }
            *(u32x4*)(H + (size_t)ROW(ai, m) * FF + COL(bj, 0)) = pack8(vv[0], vv[1]);
        }
        return 16;
    }
};
struct EpiPE {
    const float* ssr; bf16_t* T; const bf16_t* xin; bf16_t* xout; float* ssw;
    __device__ __forceinline__ void pre(const UnitD& nu, int tid, LAS float* xb) const { if (nu.sub == 0) pre_rstd(ssr, nu, tid, xb); }
    __device__ __forceinline__ int operator()(const AccT& acc, const UnitD& u, int wr, int wc, int fr, int fq, const LAS float* xb) const {
        if (u.sub == 0) {
            float rs[2][4];
            FOR_AI FOR_M rs[ai][m] = XB_RS(ai, m);
            FOR_AI FOR_M FOR_BJ *(u32x4*)(T + (size_t)ROW(ai, m) * DM + COL(bj, 0)) = pack8(sigmoid4(mul4s(acc[ai][bj][m][0], rs[ai][m])), sigmoid4(mul4s(acc[ai][bj][m][1], rs[ai][m])));
            return 16;
        }
        return x_update<false, true>(acc, u, wr, wc, fr, fq, xin, xout, ssw, nullptr, T);
    }
};

__device__ __forceinline__ void tr_item(const float* W, int ldw, int col0, const float* gs, int K, bf16_t* WT, int nrow0, LAS float* scr, int kb, int lane, int nvalid) {
    const int k0 = 64 * kb;
#pragma unroll 8
    for (int i = 0; i < 32; ++i) {
        const int kk = 2 * i + (lane >> 5), n = lane & 31;
        float v = (n < nvalid) ? W[(size_t)(k0 + kk) * ldw + col0 + n] : 0.f;
        if (gs) v *= gs[k0 + kk];
        scr[kk * 33 + n] = v;
    }
    LDS_WAIT(); asm volatile("" ::: "memory");
    const int c = lane & 7;
#pragma unroll
    for (int j = 0; j < 4; ++j) {
        const int n = (lane >> 3) + 8 * j; const LAS float* s = scr + (8 * c) * 33 + n;
        u32x4 o; o.x = cvt_pk_bf16(s[0 * 33], s[1 * 33]); o.y = cvt_pk_bf16(s[2 * 33], s[3 * 33]); o.z = cvt_pk_bf16(s[4 * 33], s[5 * 33]); o.w = cvt_pk_bf16(s[6 * 33], s[7 * 33]);
        *(u32x4*)(WT + (size_t)(nrow0 + n) * K + k0 + 8 * c) = o;
    }
    LDS_WAIT(); asm volatile("" ::: "memory");
}

__device__ __forceinline__ void prep_phase(const Params& P, int l, int grp, bf16_t* WY, bf16_t* WGM, bf16_t* WGR, LAS unsigned char* lds, int gwb, int NGW, const int tid) {
    const int lane = tid & 63, wave = __builtin_amdgcn_readfirstlane(tid >> 6);
    const int gw = gwb + wave;
    LAS float* scr = (LAS float*)(lds + wave * 16384);
    unsigned char* ws = P.ws;
    bf16_t* W1 = (bf16_t*)(ws + WS_W1);
    bf16_t* WBM = (bf16_t*)(ws + WS_WBM); bf16_t* WBR = (bf16_t*)(ws + WS_WBR); bf16_t* WOUT = (bf16_t*)(ws + WS_WOUT); bf16_t* WFF1 = (bf16_t*)(ws + WS_WFF1);
    bf16_t* WFF2 = (bf16_t*)(ws + WS_WFF2); bf16_t* WPG = (bf16_t*)(ws + WS_WPG); bf16_t* WPE = (bf16_t*)(ws + WS_WPE);
    const float* win = P.w_in + (size_t)l * DM * NIN; const float* g1 = P.norm1_g + l * DM; const float* g2 = P.norm2_g + l * DM; const float* g3 = P.norm3_g + l * DM;
    constexpr int I0 = 16 * 96, I1 = 16 * 128, I2 = 16 * 8, I3 = 16 * 32, I4 = 16 * 64, I5 = 512, I6 = 512, I7 = 512, I8 = 32 * 32, I9 = 512, I10 = 16 * 128, I11 = 64 * 32, I12 = 512, I13 = 4 * 32;
    constexpr int NA = I0 + I1 + I2 + I3 + I4 + I5 + I6, NITEMS = NA + I7 + I8 + I9 + I10 + I11 + I12 + I13;
    const int it_lo = grp == 0 ? 0 : NA, it_hi = grp == 0 ? NA : NITEMS;
    for (int it = it_lo + gw; it < it_hi; it += NGW) {
        int r = it;
        if (r < I0) { const int kb = r / 96, nb = r % 96; tr_item(win, NIN, 32 * nb, g1, DM, W1, 32 * nb, scr, kb, lane, 32); continue; } r -= I0;
        if (r < I1) { const int kb = r / 128, nb = r % 128; tr_item(win, NIN, 4104 + 32 * nb, g1, DM, W1, 3072 + 32 * nb, scr, kb, lane, 32); continue; } r -= I1;
        if (r < I2) { const int kb = r / 8, nb = r % 8; tr_item(win, NIN, 4096, g1, DM, W1, 7168 + 32 * nb, scr, kb, lane, nb == 0 ? 8 : 0); continue; } r -= I2;
        if (r < I3) { const int kb = r / 32, nb = r % 32; tr_item(win, NIN, 3072 + 32 * nb, g1, DM, WY, 32 * nb, scr, kb, lane, 32); continue; } r -= I3;
        if (r < I4) { const int kb = r / 64, nb = r % 64; tr_item(win, NIN, 8200 + 32 * nb, g1, DM, WY, 1024 + 32 * nb, scr, kb, lane, 32); continue; } r -= I4;
        if (r < I5) { const int kb = r / 32, nb = r % 32; tr_item(win, NIN, 10248 + 32 * nb, g1, DM, WGM, 32 * nb, scr, kb, lane, 32); continue; } r -= I5;
        if (r < I6) { const int kb = r / 32, nb = r % 32; tr_item(win, NIN, 11272 + 32 * nb, g1, DM, WGR, 32 * nb, scr, kb, lane, 32); continue; } r -= I6;
        if (r < I7) { const int kb = r / 32, nb = r % 32; tr_item(P.w_bm + (size_t)l * 1024 * DM, DM, 32 * nb, nullptr, 1024, WBM, 32 * nb, scr, kb, lane, 32); continue; } r -= I7;
        if (r < I8) { const int kb = r / 32, nb = r % 32; tr_item(P.w_br + (size_t)l * 2048 * DM, DM, 32 * nb, nullptr, 2048, WBR, 32 * nb, scr, kb, lane, 32); continue; } r -= I8;
        if (r < I9) { const int kb = r / 32, nb = r % 32; tr_item(P.w_out + (size_t)l * DM * DM, DM, 32 * nb, nullptr, DM, WOUT, 32 * nb, scr, kb, lane, 32); continue; } r -= I9;
        if (r < I10) { const int kb = r / 128, nb = r % 128; tr_item(P.w_ff1 + (size_t)l * DM * FF, FF, 32 * nb, g2, DM, WFF1, 32 * nb, scr, kb, lane, 32); continue; } r -= I10;
        if (r < I11) { const int kb = r / 32, nb = r % 32; tr_item(P.w_ff2 + (size_t)l * FF * DM, DM, 32 * nb, nullptr, FF, WFF2, 32 * nb, scr, kb, lane, 32); continue; } r -= I11;
        if (r < I12) { const int kb = r / 32, nb = r % 32; tr_item(P.w_pe_gate + (size_t)l * DM * DM, DM, 32 * nb, g3, DM, WPG, 32 * nb, scr, kb, lane, 32); continue; } r -= I12;
        { const int kb = r / 32, nb = r % 32; tr_item(P.w_pe + (size_t)l * PED * DM, DM, 32 * nb, nullptr, PED, WPE, 32 * nb, scr, kb, lane, 32); }
    }
}

__device__ __forceinline__ void pconv_phase(const Params& P, int l, int gwb, int NGW, const int tid) {
    const int lane = tid & 63, wave = __builtin_amdgcn_readfirstlane(tid >> 6);
    const int gw = gwb + wave;
    unsigned char* ws = P.ws;
    {
        const float* pl = P.p + (size_t)l * NTOK * PED; bf16_t* PB = (bf16_t*)(ws + WS_PB);
        const size_t nchunk = (size_t)NTOK * PED / 8;
        for (size_t i = (size_t)gw * 64 + lane; i < nchunk; i += (size_t)NGW * 64) {
            const f32x4 a = *(const f32x4*)(pl + i * 8), b = *(const f32x4*)(pl + i * 8 + 4);
            u32x4 o; o.x = cvt_pk_bf16(a[0], a[1]); o.y = cvt_pk_bf16(a[2], a[3]); o.z = cvt_pk_bf16(b[0], b[1]); o.w = cvt_pk_bf16(b[2], b[3]);
            *(u32x4*)(PB + i * 8) = o;
        }
    }
}

__device__ __forceinline__ void prep0_phase(const Params& P, int vcu, int G, const int tid) {
    const int lane = tid & 63, wave = __builtin_amdgcn_readfirstlane(tid >> 6);
    const int gw = vcu * 8 + wave, NGW = G * 8;
    unsigned char* ws = P.ws;
    {
        bf16_t* XB = (bf16_t*)(ws + WS_XB0); float* ss = (float*)(ws + WS_SS0);
        for (int row = gw; row < NTOK; row += NGW) {
            const f32x4* xr = (const f32x4*)(P.x + (size_t)row * DM) + lane;
            float s = 0.f;
#pragma unroll
            for (int j = 0; j < 4; ++j) {
                const f32x4 v = xr[64 * j];
                s += (v[0] * v[0] + v[1] * v[1]) + (v[2] * v[2] + v[3] * v[3]);
                *((u32x2*)(XB + (size_t)row * DM) + lane + 64 * j) = pack4(v);
            }
#pragma unroll
            for (int o = 1; o < 64; o <<= 1) s += __shfl_xor(s, o);
            if (lane < 16) ss[(size_t)row * 16 + lane] = (lane == 0) ? s : 0.f;
        }
        float* rc = (float*)(ws + WS_ROPE); float* rsn = rc + (size_t)SEQ * 128;
        for (int i = (vcu * 512 + tid); i < SEQ * 128; i += G * 512) {
            const int pos = i >> 7, j = i & 127;
            const double invf = exp2(-(double)j * (13.287712379549449 / 128.0));
            double ang = (double)pos * invf;
            const double k = rint(ang * 0.15915494309189535);
            ang = ang - k * 6.283185307179586;
            const float af = (float)ang;
            rc[i] = cosf(af); rsn[i] = sinf(af);
        }
    }
}

constexpr int QP = 544, VP = 144, VRP = 208, OBP = 336;
constexpr int S_Q = 0, S_K = 34816, S_ST = 69632, S_VT = 113152, S_VW = 126464, S_P = 139776, S_VEC = 148992;
static_assert(S_K == 64 * QP && S_ST == 2 * 64 * QP && S_VT == S_ST + 80 * QP && S_VW == S_VT + 64 * VRP && S_P == S_VW + 64 * VRP && S_VEC == S_P + 64 * VP && S_VEC + 1024 <= LDS_BYTES - 64, "scan LDS map");
__device__ __forceinline__ s16x4 tr_read(const LAS unsigned char* p) {
    typedef short v4i16_t __attribute__((ext_vector_type(4)));
    return __builtin_bit_cast(s16x4, __builtin_amdgcn_ds_read_tr16_b64_v4i16((LAS v4i16_t*)p));
}
#define MFMA16(a, b, c) __builtin_amdgcn_mfma_f32_16x16x32_bf16((a), (b), (c), 0, 0, 0)

__device__ __forceinline__ void prescan_phase(const Params& P, int l, bf16_t* QC, bf16_t* KC, int vcu, int G, const int tid) {
    const int lane = tid & 63, wave = __builtin_amdgcn_readfirstlane(tid >> 6);
    bf16_t* Z = (bf16_t*)(P.ws + WS_Z);
    const int gt = vcu * 512 + tid, NT = G * 512;
    for (int it = gt; it < (NTOK / 4) * 256; it += NT) {
        const int cc = it & 255, tgp = it >> 8, ch = cc * 8, mat = ch >> 10, rowb = 4 * tgp, pos0 = rowb & (SEQ - 1);
        const float* cw = P.conv_w + (size_t)l * 8192 + ch; const float* cb = P.conv_b + (size_t)l * 2048 + ch;
        u32x4 raw[7];
#pragma unroll
        for (int i = 0; i < 7; ++i) {
            raw[i] = (u32x4){0u, 0u, 0u, 0u};
            if (pos0 - 3 + i >= 0) raw[i] = *(const u32x4*)(Z + (size_t)(rowb - 3 + i) * ZW + ch);
        }
        f32x4 wv[4][2], bb[2];
#pragma unroll
        for (int j = 0; j < 4; ++j) { wv[j][0] = *(const f32x4*)(cw + j * 2048); wv[j][1] = *(const f32x4*)(cw + j * 2048 + 4); }
        bb[0] = *(const f32x4*)cb; bb[1] = *(const f32x4*)(cb + 4);
        bf16_t* dst = (mat ? KC : QC) + (size_t)rowb * 1024 + (ch & 1023);
        const float sc = mat ? 1.f : 0.0625f;
#pragma unroll
        for (int tt = 0; tt < 4; ++tt) {
            f32x4 o0 = bb[0], o1 = bb[1];
#pragma unroll
            for (int j = 0; j < 4; ++j) {
                const u32x4 rw = raw[tt + j];
                o0 = o0 + wv[j][0] * (f32x4){bflo(rw.x), bfhi(rw.x), bflo(rw.y), bfhi(rw.y)};
                o1 = o1 + wv[j][1] * (f32x4){bflo(rw.z), bfhi(rw.z), bflo(rw.w), bfhi(rw.w)};
            }
            o0 = o0 * sigmoid4(o0) * sc; o1 = o1 * sigmoid4(o1) * sc;
            u32x4 pk; pk.x = cvt_pk_bf16(o0[0], o0[1]); pk.y = cvt_pk_bf16(o0[2], o0[3]); pk.z = cvt_pk_bf16(o1[0], o1[1]); pk.w = cvt_pk_bf16(o1[2], o1[3]);
            *(u32x4*)(dst + (size_t)tt * 1024) = pk;
        }
    }
    const float* gates = (const float*)(P.ws + WS_GATES); f32x4* GV = (f32x4*)(P.ws + WS_GV);
    for (int task = vcu * 8 + wave; task < (NTOK / 64) * 4; task += G * 8) {
        const int h = task & 3, row = (task >> 2) * 64 + lane;
        const float li = gates[(size_t)row * 8 + h], mf = gates[(size_t)row * 8 + 4 + h];
        const float lf = fminf(mf, 0.f) - log1pf(expf(-fabsf(mf)));
        float bcs = lf;
#pragma unroll
        for (int o = 1; o < 64; o <<= 1) { const float v = __shfl_up(bcs, o); if (lane >= o) bcs += v; }
        const float a = li - bcs;
        float pm = a;
#pragma unroll
        for (int o = 1; o < 64; o <<= 1) { const float v = __shfl_up(pm, o); if (lane >= o) pm = fmaxf(pm, v); }
        GV[(size_t)row * 4 + h] = (f32x4){a, pm, bcs, 0.f};
    }
}

__device__ __forceinline__ void scan_phase(const Params& P, int l, const bf16_t* QC, const bf16_t* KC, LAS unsigned char* lds, int vcu, const int tid) {
    if (vcu >= 192) return;
    const int lane = tid & 63, wid = __builtin_amdgcn_readfirstlane(tid >> 6), r = lane & 15, q = lane >> 4;
    const bool isM = vcu < 64;
    int bh, slice; if (isM) { bh = vcu >> 2; slice = vcu & 3; } else { const int t = vcu - 64; bh = t >> 3; slice = t & 7; }
    const int b = bh >> 2, h = bh & 3;
    const int vcol = isM ? 2048 + h * 256 + slice * 64 : 5120 + h * 512 + slice * 64;
    const int hidx = isM ? h : 4 + h;
    bf16_t* Z = (bf16_t*)(P.ws + WS_Z);
    const f32x4* GV = (const f32x4*)(P.ws + WS_GV);
    float* hstat = (float*)(P.ws + WS_HSTAT);
    const bf16_t* qsrc = isM ? QC + (size_t)b * SEQ * 1024 + h * 256 : Z + (size_t)b * SEQ * ZW + 3072 + h * 256;
    const bf16_t* ksrc = isM ? KC + (size_t)b * SEQ * 1024 + h * 256 : Z + (size_t)b * SEQ * ZW + 4096 + h * 256;
    const size_t qkp = isM ? 1024 : ZW;
    LAS unsigned char* SQ = lds + S_Q; LAS unsigned char* SK = lds + S_K; LAS unsigned char* SST = lds + S_ST; LAS unsigned char* SVT = lds + S_VT;
    LAS unsigned char* SVW = lds + S_VW; LAS unsigned char* SP = lds + S_P; LAS unsigned char* OB = lds + S_Q;
    LAS float* vecU = (LAS float*)(lds + S_VEC); LAS float* vecA = vecU + 64; LAS float* vecDI = vecU + 128; LAS float* vecEN = vecU + 192;
    { unsigned zz = 0u; asm volatile("" : "+v"(zz)); const u32x4 z4 = (u32x4){zz, zz, zz, zz};
      for (int i = tid; i < (S_P - S_ST) / 16; i += 512) *(LAS u32x4*)(SST + i * 16) = z4; }
    __syncthreads();
    if (isM && tid < 64) *(LAS bf16_t*)(SVT + tid * VRP + 128) = (bf16_t)0x3F80;
    f32x4 accS[2][5];
#pragma unroll
    for (int i = 0; i < 2; ++i)
#pragma unroll
        for (int v = 0; v < 5; ++v) accS[i][v] = (f32x4){0.f, 0.f, 0.f, 0.f};
    float m_prev = 0.f;
    const float lg = logf(1.f - exp2f(-5.f - (float)h));
    const float r_u = (float)lane * lg, r_a = -(float)lane * lg, r_di = expf((float)(lane + 1) * lg), r_w = expf((float)(63 - lane) * lg), r_dec = expf(64.f * lg);
    u32x4 pq[4], pk[4], pv; f32x4 pg = (f32x4){0.f, 0.f, 0.f, 0.f};
    const int lt = tid >> 5, lc = tid & 31;
#define SCAN_ISSUE(c_) do { const size_t rb_ = (size_t)(c_) * 64; \
        _Pragma("unroll") for (int i_ = 0; i_ < 4; ++i_) { pq[i_] = *(const u32x4*)(qsrc + (rb_ + lt + 16 * i_) * qkp + lc * 8); pk[i_] = *(const u32x4*)(ksrc + (rb_ + lt + 16 * i_) * qkp + lc * 8); } \
        pv = *(const u32x4*)(Z + ((size_t)b * SEQ + rb_ + (tid >> 3)) * ZW + vcol + (tid & 7) * 8); \
        if (isM) pg = GV[((size_t)b * SEQ + rb_ + lane) * 4 + h]; } while (0)
    SCAN_ISSUE(0);
    __syncthreads();
#define SCAN_BAR() asm volatile("s_waitcnt lgkmcnt(0)\n\ts_barrier" ::: "memory")

    for (int c = 0; c < SEQ / 64; ++c) {
        const int row0 = b * SEQ + c * 64;
        float u_t, a_s, di, en, w, decay, m_new;
        if (isM) {
            const float a = pg[0] + pg[3], pm = pg[1], bcs = pg[2];
            const float Mt = fmaxf(m_prev, pm);
            u_t = -Mt; a_s = a; di = __expf(m_prev - Mt); en = __expf(-(bcs + Mt));
            const float Mend = __builtin_bit_cast(float, __builtin_amdgcn_readlane(__builtin_bit_cast(int, Mt), 63));
            const float bend = __builtin_bit_cast(float, __builtin_amdgcn_readlane(__builtin_bit_cast(int, bcs), 63));
            w = __expf(a - Mend); decay = __expf(m_prev - Mend); m_new = bend + Mend;
        } else { u_t = r_u; a_s = r_a; di = r_di; en = 1.f; w = r_w; decay = r_dec; m_new = 0.f; }
        if (wid == 0) { vecU[lane] = u_t; vecA[lane] = a_s; vecDI[lane] = di; vecEN[lane] = en; }
#pragma unroll
        for (int i = 0; i < 4; ++i) { *(LAS u32x4*)(SQ + (lt + 16 * i) * QP + lc * 16) = pq[i]; *(LAS u32x4*)(SK + (lt + 16 * i) * QP + lc * 16) = pk[i]; }
        {
            const int vs = tid >> 3, vch = tid & 7;
            const float ws = __shfl(w, vs);
            *(LAS u32x4*)(SVT + vs * VRP + vch * 16) = pv;
            u32x4 pw; pw.x = cvt_pk_bf16(bflo(pv.x) * ws, bfhi(pv.x) * ws); pw.y = cvt_pk_bf16(bflo(pv.y) * ws, bfhi(pv.y) * ws);
            pw.z = cvt_pk_bf16(bflo(pv.z) * ws, bfhi(pv.z) * ws); pw.w = cvt_pk_bf16(bflo(pv.w) * ws, bfhi(pv.w) * ws);
            *(LAS u32x4*)(SVW + vs * VRP + vch * 16) = pw;
            if (isM && wid == 0) *(LAS bf16_t*)(SVW + lane * VRP + 128) = (bf16_t)(cvt_pk_bf16(w, 0.f) & 0xffffu);
        }
        if (c + 1 < SEQ / 64) SCAN_ISSUE(c + 1);
        SCAN_BAR();
        {
            const int sm = wid >> 1, tn0 = (wid & 1) * 2;
            f32x4 sa[2] = {(f32x4){0.f, 0.f, 0.f, 0.f}, (f32x4){0.f, 0.f, 0.f, 0.f}};
            if (sm <= tn0 + 1) {
#pragma unroll
                for (int kb = 0; kb < 2; ++kb) {
                    bf16x8 fa[4], fb0[4], fb1[4];
#pragma unroll
                    for (int j = 0; j < 4; ++j) {
                        const int kk = kb * 4 + j;
                        fa[j] = *(const LAS bf16x8*)(SK + (sm * 16 + r) * QP + kk * 64 + q * 16);
                        fb0[j] = *(const LAS bf16x8*)(SQ + (tn0 * 16 + r) * QP + kk * 64 + q * 16);
                        fb1[j] = *(const LAS bf16x8*)(SQ + ((tn0 + 1) * 16 + r) * QP + kk * 64 + q * 16);
                    }
#pragma unroll
                    for (int j = 0; j < 4; ++j) { sa[0] = MFMA16(fa[j], fb0[j], sa[0]); sa[1] = MFMA16(fa[j], fb1[j], sa[1]); }
                }
            }
            const int s0 = sm * 16 + 4 * q;
            const f32x4 a4 = *(const LAS f32x4*)(vecA + s0);
#pragma unroll
            for (int i = 0; i < 2; ++i) {
                const int t = (tn0 + i) * 16 + r; const float ut = vecU[t];
                f32x4 pv;
#pragma unroll
                for (int j = 0; j < 4; ++j) pv[j] = (s0 + j <= t) ? sa[i][j] * __expf(ut + a4[j]) : 0.f;
                *(LAS u32x2*)(SP + t * VP + s0 * 2) = pack4(pv);
            }
        }
        SCAN_BAR();
        const int tn = wid & 3, vt0 = (wid >> 2) ? 3 : 0, nvt = (wid >> 2) ? 2 : 3;
        f32x4 oo[3];
        {
            f32x4 o1[3], o2[3];
#pragma unroll
            for (int i = 0; i < 3; ++i) { o1[i] = (f32x4){0.f, 0.f, 0.f, 0.f}; o2[i] = (f32x4){0.f, 0.f, 0.f, 0.f}; }
#pragma unroll
            for (int ks = 0; ks < 2; ++ks) {
                const bf16x8 bP = *(const LAS bf16x8*)(SP + (tn * 16 + r) * VP + ks * 64 + q * 16);
#pragma unroll
                for (int i = 0; i < 3; ++i) if (i < nvt) {
                    const LAS unsigned char* vb = SVT + (32 * ks + 8 * q + ((lane & 15) >> 2)) * VRP + (16 * (vt0 + i)) * 2 + 8 * (lane & 3);
                    const s16x4 vlo = tr_read(vb), vhi = tr_read(vb + 4 * VRP);
                    const bf16x8 aV = __builtin_shufflevector(vlo, vhi, 0, 1, 2, 3, 4, 5, 6, 7);
                    o1[i] = MFMA16(aV, bP, o1[i]);
                }
            }
#pragma unroll
            for (int kb = 0; kb < 4; ++kb) {
                bf16x8 fq[2], fs[2][3];
#pragma unroll
                for (int j = 0; j < 2; ++j) {
                    const int kk = kb * 2 + j;
                    fq[j] = *(const LAS bf16x8*)(SQ + (tn * 16 + r) * QP + kk * 64 + q * 16);
#pragma unroll
                    for (int i = 0; i < 3; ++i) if (i < nvt) fs[j][i] = *(const LAS bf16x8*)(SST + ((vt0 + i) * 16 + r) * QP + kk * 64 + q * 16);
                }
#pragma unroll
                for (int j = 0; j < 2; ++j)
#pragma unroll
                    for (int i = 0; i < 3; ++i) if (i < nvt) o2[i] = MFMA16(fs[j][i], fq[j], o2[i]);
            }
            const float dit = vecDI[tn * 16 + r];
#pragma unroll
            for (int i = 0; i < 3; ++i) oo[i] = o1[i] + o2[i] * dit;
        }
        {
#pragma unroll
            for (int i = 0; i < 2; ++i)
#pragma unroll
                for (int v = 0; v < 5; ++v) accS[i][v] = accS[i][v] * decay;
            const int qq = (lane & 15) >> 2, pp = lane & 3;
#pragma unroll
            for (int ks = 0; ks < 2; ++ks) {
                bf16x8 aK[2];
#pragma unroll
                for (int i = 0; i < 2; ++i) {
                    const LAS unsigned char* base = SK + (32 * ks + 8 * q + qq) * QP + (16 * (2 * wid + i)) * 2 + 8 * pp;
                    const s16x4 lo = tr_read(base), hi = tr_read(base + 4 * QP);
                    aK[i] = __builtin_shufflevector(lo, hi, 0, 1, 2, 3, 4, 5, 6, 7);
                }
#pragma unroll
                for (int v = 0; v < 5; ++v) {
                    const LAS unsigned char* wb = SVW + (32 * ks + 8 * q + qq) * VRP + (16 * v) * 2 + 8 * pp;
                    const s16x4 wlo = tr_read(wb), whi = tr_read(wb + 4 * VRP);
                    const bf16x8 bV = __builtin_shufflevector(wlo, whi, 0, 1, 2, 3, 4, 5, 6, 7);
                    accS[0][v] = MFMA16(aK[0], bV, accS[0][v]); accS[1][v] = MFMA16(aK[1], bV, accS[1][v]);
                }
            }
        }
        SCAN_BAR();
#pragma unroll
        for (int i = 0; i < 3; ++i) if (i < nvt) *(LAS f32x4*)(OB + (tn * 16 + r) * OBP + ((vt0 + i) * 16 + 4 * q) * 4) = oo[i];
#pragma unroll
        for (int i = 0; i < 2; ++i)
#pragma unroll
            for (int v = 0; v < 5; ++v) *(LAS u32x2*)(SST + (v * 16 + r) * QP + ((2 * wid + i) * 16 + 4 * q) * 2) = pack4(accS[i][v]);
        SCAN_BAR();
        {
            const int t = tid >> 3, vc = tid & 7;
            f32x4 n0 = *(const LAS f32x4*)(OB + t * OBP + vc * 32), n1 = *(const LAS f32x4*)(OB + t * OBP + vc * 32 + 16);
            if (isM) {
                const float den = *(const LAS float*)(OB + t * OBP + 256);
                const float inv = 1.f / fmaxf(fabsf(den), vecEN[t]);
                n0 = n0 * inv; n1 = n1 * inv;
            }
            float s = (n0[0] + n0[1]) + (n0[2] + n0[3]) + (n1[0] + n1[1]) + (n1[2] + n1[3]);
            float sq = (n0[0] * n0[0] + n0[1] * n0[1]) + (n0[2] * n0[2] + n0[3] * n0[3]) + (n1[0] * n1[0] + n1[1] * n1[1]) + (n1[2] * n1[2] + n1[3] * n1[3]);
            s += __shfl_xor(s, 1); s += __shfl_xor(s, 2); s += __shfl_xor(s, 4);
            sq += __shfl_xor(sq, 1); sq += __shfl_xor(sq, 2); sq += __shfl_xor(sq, 4);
            if (vc == 0) *(f32x2*)(hstat + ((size_t)(row0 + t) * 8 + hidx) * 16 + slice * 2) = (f32x2){s, sq};
            u32x4 pk; pk.x = cvt_pk_bf16(n0[0], n0[1]); pk.y = cvt_pk_bf16(n0[2], n0[3]); pk.z = cvt_pk_bf16(n1[0], n1[1]); pk.w = cvt_pk_bf16(n1[2], n1[3]);
            *(u32x4*)(Z + (size_t)(row0 + t) * ZW + vcol + vc * 8) = pk;
        }
        m_prev = m_new;
        SCAN_BAR();
    }
}


#define XB_TMO      128
#define XB_XCNT(j)  (256  + 64 * (j))
#define XB_XSUB(j)  (1280 + 64 * (j))
#define XB_XGEN(j)  (2304 + 64 * (j))
#define XB_TOP      3328
#define XB_TOPGEN   3392
#define XCD_BAR_WORDS 3456
#define XB_SPIN_CAP (1u << 18)
__device__ __forceinline__ unsigned xb_ld(unsigned* p)              { return __hip_atomic_load(p, __ATOMIC_RELAXED, __HIP_MEMORY_SCOPE_AGENT); }
__device__ __forceinline__ unsigned xb_add(unsigned* p, unsigned v) { return __hip_atomic_fetch_add(p, v, __ATOMIC_RELAXED, __HIP_MEMORY_SCOPE_AGENT); }
__device__ __forceinline__ unsigned xb_xcc_id() { return (unsigned)__builtin_amdgcn_s_getreg((3 << 11) | 20) & 0xFu; }
#define XB_SPIN(cond, bar) do { unsigned _sp = 0; while (cond) { __builtin_amdgcn_s_sleep(1); \
    if ((++_sp & 255u) == 0u) { if (xb_ld(&(bar)[XB_TMO])) break; if (_sp > XB_SPIN_CAP) { atomicAdd(&(bar)[XB_TMO], 1u); break; } } } } while (0)
struct XcdBarrier { unsigned* bar; unsigned x; volatile LAS unsigned* st; };
__device__ __forceinline__ XcdBarrier xcd_barrier_post(unsigned* bar, volatile LAS unsigned* st, const bool t0) {
    XcdBarrier b; b.bar = bar; b.x = xb_xcc_id(); b.st = st;
    if (t0) (void)xb_add(&bar[XB_XCNT(b.x)], 1u);
    return b;
}
__device__ __forceinline__ void xcd_barrier_complete(unsigned* bar, unsigned x, unsigned& nloc, unsigned& nx) {
    const unsigned G = gridDim.x * gridDim.y * gridDim.z;
    unsigned sum, cnt, mine, sp = 0u;
    for (;;) {
        sum = 0u; cnt = 0u; mine = 0u;
#pragma unroll
        for (unsigned j = 0; j < 16; ++j) { const unsigned c = xb_ld(&bar[XB_XCNT(j)]); sum += c; cnt += (c > 0u) ? 1u : 0u; mine = (j == x) ? c : mine; }
        if (sum == G) break;
        __builtin_amdgcn_s_sleep(1);
        if ((++sp & 255u) == 0u) { if (xb_ld(&bar[XB_TMO])) break; if (sp > XB_SPIN_CAP) { atomicAdd(&bar[XB_TMO], 1u); break; } }
    }
    nloc = mine > 0u ? mine : 1u; nx = cnt > 0u ? cnt : 1u;
}
__device__ __forceinline__ void xcd_barrier(const XcdBarrier& b, const bool t0) {
    asm volatile("s_waitcnt vmcnt(0)" ::: "memory");
    __syncthreads();
    if (t0) {
        unsigned* bar = b.bar;
        __builtin_amdgcn_s_waitcnt(0);
        unsigned nloc = b.st[0], nx = b.st[1];
        if (nloc == 0u) { xcd_barrier_complete(bar, b.x, nloc, nx); b.st[0] = nloc; b.st[1] = nx; }
        const unsigned old = xb_add(&bar[XB_XSUB(b.x)], 1u);
        const unsigned gen = old / nloc;
        if (old + 1u == (gen + 1u) * nloc) {
            __builtin_amdgcn_fence(__ATOMIC_RELEASE, "agent");
            asm volatile("s_waitcnt vmcnt(0)" ::: "memory");
            const unsigned og = xb_add(&bar[XB_TOP], 1u);
            const unsigned tg = og / nx;
            if (og + 1u == (tg + 1u) * nx) xb_add(&bar[XB_TOPGEN], 1u);
            else XB_SPIN(xb_ld(&bar[XB_TOPGEN]) == tg, bar);
            __builtin_amdgcn_fence(__ATOMIC_ACQUIRE, "agent");
            xb_add(&bar[XB_XGEN(b.x)], 1u);
            asm volatile("s_waitcnt vmcnt(0)" ::: "memory");
        } else {
            XB_SPIN(xb_ld(&bar[XB_XGEN(b.x)]) == gen, bar);
            __builtin_amdgcn_fence(__ATOMIC_ACQUIRE, "agent");
            asm volatile("s_waitcnt vmcnt(0)" ::: "memory");
        }
    }
    __syncthreads();
}

#ifndef PHMASK
#define PHMASK 0xFFFF
#endif
#define PH(n) ((PHMASK >> (n)) & 1)
#define LQ() int lq = l; unsigned char* ws = P.ws; asm volatile("" : "+s"(lq)); asm volatile("" : "+s"(ws)); \
    bf16_t* Z = (bf16_t*)(ws + WS_Z); bf16_t* MG = (bf16_t*)(ws + WS_MG); float* gates = (float*)(ws + WS_GATES); float* hstat = (float*)(ws + WS_HSTAT); \
    bf16_t* XBc = (bf16_t*)(ws + ((lq & 1) ? WS_XB1 : WS_XB0)); bf16_t* XBn = (bf16_t*)(ws + ((lq & 1) ? WS_XB0 : WS_XB1)); \
    float* ssc = (float*)(ws + ((lq & 1) ? WS_SS1 : WS_SS0)); float* ssn = (float*)(ws + ((lq & 1) ? WS_SS0 : WS_SS1)); \
    const float* bin = P.b_in + (size_t)lq * NIN; \
    bf16_t* WYc = (bf16_t*)(ws + ((lq & 1) ? WS_WY1 : WS_WY)); bf16_t* WYn = (bf16_t*)(ws + ((lq & 1) ? WS_WY : WS_WY1)); \
    bf16_t* WGMc = (bf16_t*)(ws + ((lq & 1) ? WS_WGM1 : WS_WGM)); bf16_t* WGMn = (bf16_t*)(ws + ((lq & 1) ? WS_WGM : WS_WGM1)); \
    bf16_t* WGRc = (bf16_t*)(ws + ((lq & 1) ? WS_WGR1 : WS_WGR)); bf16_t* WGRn = (bf16_t*)(ws + ((lq & 1) ? WS_WGR : WS_WGR1)); \
    (void)Z; (void)MG; (void)gates; (void)hstat; (void)XBc; (void)XBn; (void)ssc; (void)ssn; (void)bin; (void)WYc; (void)WYn; (void)WGMc; (void)WGMn; (void)WGRc; (void)WGRn
#define OPQ() int tq = wave * 64 + lane_id_fresh(), vcuq = vcu, Gq = G; asm volatile("" : "+s"(vcuq), "+s"(Gq))
__global__ void __launch_bounds__(512, 2) fwd_megakernel(Params P) {
    extern __shared__ __attribute__((aligned(16))) unsigned char lds_raw[];
    LAS unsigned char* lds = (LAS unsigned char*)lds_raw;
    cg::grid_group grid = cg::this_grid();
    const int G = gridDim.x, bx = blockIdx.x;
    const int vcu = (G % 8 == 0) ? (bx % 8) * (G / 8) + bx / 8 : bx;
    const int wave = __builtin_amdgcn_readfirstlane((int)threadIdx.x >> 6);
    unsigned* barw = (unsigned*)(P.ws + WS_CTL);
    volatile LAS unsigned* bst = (volatile LAS unsigned*)(lds + LDS_BYTES - 64);
    { const int tid0 = threadIdx.x; if (bx == 0) for (int i = tid0; i < XCD_BAR_WORDS; i += 512) barw[i] = 0u;
      if (tid0 < 2) bst[tid0] = 0u; }
    XcdBarrier xbar; xbar.bar = barw; xbar.x = 0; xbar.st = bst;
    bool posted = false;
#define LANEID() ((int)__builtin_amdgcn_mbcnt_hi(~0u, __builtin_amdgcn_mbcnt_lo(~0u, 0u)))
#define GSYNC() do { const bool t0_ = (wave == 0) && (lane_id_fresh() == 0); if (!posted) { grid.sync(); xbar = xcd_barrier_post(barw, bst, t0_); posted = true; } else xcd_barrier(xbar, t0_); } while (0)
    { OPQ(); prep0_phase(P, vcuq, Gq, tq); }
    for (int l = 0; l < NLAYER; ++l) {
        if (l == 0) { { LQ(); OPQ(); prep_phase(P, 0, 0, WYc, WGMc, WGRc, lds, vcuq * 8, Gq * 8, tq); } GSYNC(); }
        if (PH(1)) {
            LQ();
            Sched<1> S; S.T.init(NTOK, 7424, G, bx);
            S.g0 = SubG{(const char*)XBc, (const char*)(ws + WS_W1), 2048u, 2048u, 16}; S.g1 = S.g0; S.g2 = S.g0; S.g3 = S.g0;
            EpiIn E{ssc, bin, Z, gates, (const float*)(ws + WS_ROPE)};
            { OPQ(); gemm_phase(lds, S, E, tq); }
        }
        GSYNC();
        if (PH(2)) { LQ(); OPQ(); prescan_phase(P, lq, MG, XBn, vcuq, Gq, tq); pconv_phase(P, lq, vcuq * 8, Gq * 8, tq); }
        GSYNC();
        if (PH(2)) { LQ(); OPQ(); scan_phase(P, lq, MG, XBn, lds, vcuq, tq); }
        if (vcu >= 192) {   LQ();
            { OPQ(); prep_phase(P, lq, 1, WYn, WGMn, WGRn, lds, (vcuq - 192) * 8, 512, tq); }
            if (lq + 1 < NLAYER) { OPQ(); prep_phase(P, lq + 1, 0, WYn, WGMn, WGRn, lds, (vcuq - 192) * 8, 512, tq); }
            __syncthreads();
            Sched<1> S; S.T.init(NTOK, 1024, 64, vcu - 192);
            S.g0 = SubG{(const char*)XBc, (const char*)WGMc, 2048u, 2048u, 16}; S.g1 = S.g0; S.g2 = S.g0; S.g3 = S.g0;
            EpiMerge E{ssc, bin, Z, MG, 0};
            { OPQ(); gemm_phase(lds, S, E, tq); }
        }
        GSYNC();
        if (PH(3)) {
            LQ();
            Sched<1> S; S.T.init(NTOK, 3072, G, bx);
            S.g0 = SubG{(const char*)XBc, (const char*)WYc, 2048u, 2048u, 16}; S.g1 = S.g0; S.g2 = S.g0; S.g3 = S.g0;
            EpiY E{ssc, bin, Z, hstat, P.m_norm_g + lq * 1024, P.r_norm_g + lq * 2048};
            { OPQ(); gemm_phase(lds, S, E, tq); }
        }
        GSYNC();
        if (PH(4)) {
            LQ();
            Sched<3> S; S.T.init(NTOK, 1024, G, bx);
            S.g0 = SubG{(const char*)(Z + 2048), (const char*)(ws + WS_WBM), (unsigned)(ZW * 2), 2048u, 16};
            S.g1 = SubG{(const char*)XBc, (const char*)WGRc, 2048u, 2048u, 16};
            S.g2 = SubG{(const char*)(Z + 5120), (const char*)(ws + WS_WBR), (unsigned)(ZW * 2), 4096u, 32};
            S.g3 = S.g0;
            EpiMerge E{ssc, bin, Z, MG, 1};
            { OPQ(); gemm_phase(lds, S, E, tq); }
        }
        GSYNC();
        if (PH(5)) {
            LQ();
            Sched<1> S; S.T.init(NTOK, 1024, G, bx);
            S.g0 = SubG{(const char*)MG, (const char*)(ws + WS_WOUT), 2048u, 2048u, 16}; S.g1 = S.g0; S.g2 = S.g0; S.g3 = S.g0;
            EpiX E{XBc, XBc, ssc, nullptr};
            { OPQ(); gemm_phase(lds, S, E, tq); }
        }
        GSYNC();
        if (PH(6)) {
            LQ();
            Sched<1> S; S.T.init(NTOK, FF, G, bx);
            S.g0 = SubG{(const char*)XBc, (const char*)(ws + WS_WFF1), 2048u, 2048u, 16}; S.g1 = S.g0; S.g2 = S.g0; S.g3 = S.g0;
            EpiFF1 E{ssc, P.b_ff1 + (size_t)lq * FF, Z};
            { OPQ(); gemm_phase(lds, S, E, tq); }
        }
        GSYNC();
        if (PH(7)) {
            LQ();
            Sched<1> S; S.T.init(NTOK, 1024, G, bx);
            S.g0 = SubG{(const char*)Z, (const char*)(ws + WS_WFF2), 8192u, 8192u, 64}; S.g1 = S.g0; S.g2 = S.g0; S.g3 = S.g0;
            EpiX E{XBc, XBc, ssc, P.b_ff2 + (size_t)lq * DM};
            { OPQ(); gemm_phase(lds, S, E, tq); }
        }
        GSYNC();
        if (PH(8)) {
            LQ();
            Sched<2> S; S.T.init(NTOK, 1024, G, bx);
            S.g0 = SubG{(const char*)XBc, (const char*)(ws + WS_WPG), 2048u, 2048u, 16};
            S.g1 = SubG{(const char*)(ws + WS_PB), (const char*)(ws + WS_WPE), 512u, 512u, 4};
            S.g2 = S.g0; S.g3 = S.g0;
            EpiPE E{ssc, Z, XBc, XBn, ssn};
            { OPQ(); gemm_phase(lds, S, E, tq); }
        }
        GSYNC();
    }
    {
        unsigned char* ws = P.ws;
        const float* ss = (const float*)(ws + WS_SS0);
        const bf16_t* XBf = (const bf16_t*)(ws + WS_XB0);
        const int lane = lane_id_fresh();
        const int gw = vcu * 8 + wave, NGW = G * 8;
        for (int row = gw; row < NTOK; row += NGW) {
            float s = (lane < 16) ? ss[(size_t)row * 16 + lane] : 0.f;
#pragma unroll
            for (int o = 1; o < 64; o <<= 1) s += __shfl_xor(s, o);
            const float rs = rsqrtf(s * (1.f / DM) + EPS);
#pragma unroll
            for (int j = 0; j < 2; ++j) {
                const u32x4 w = *((const u32x4*)(XBf + (size_t)row * DM) + lane + 64 * j);
                f32x4 x0, x1; unpack8(w, x0, x1);
                const f32x4 g0 = *((const f32x4*)P.final_g + 2 * (lane + 64 * j)), g1 = *((const f32x4*)P.final_g + 2 * (lane + 64 * j) + 1);
                f32x4* o = (f32x4*)(P.out + (size_t)row * DM) + 2 * (lane + 64 * j);
                o[0] = x0 * rs * g0; o[1] = x1 * rs * g1;
            }
        }
    }
}

extern "C" void kernel_launch(void* const* d_in, const int* in_sizes, int n_in, void* d_out, int out_size, void* d_ws, size_t ws_size, hipStream_t stream) {
    static int grid = 0;
    if (grid == 0) {
        if (n_in != 21 || out_size != NTOK * DM || ws_size < WS_END) { fprintf(stderr, "kernel_launch: unexpected shapes / workspace (n_in %d out %d ws %zu)\n", n_in, out_size, ws_size); grid = -1; return; }
        int dev = 0, cus = 0, per_cu = 0;
        (void)hipGetDevice(&dev);
        (void)hipDeviceGetAttribute(&cus, hipDeviceAttributeMultiprocessorCount, dev);
        (void)hipFuncSetAttribute((const void*)fwd_megakernel, hipFuncAttributeMaxDynamicSharedMemorySize, LDS_BYTES);
        (void)hipOccupancyMaxActiveBlocksPerMultiprocessor(&per_cu, (const void*)fwd_megakernel, 512, LDS_BYTES);
        (void)hipGetLastError();
        if (per_cu < 1) per_cu = 1;
        grid = cus;
    }
    if (grid < 0) return;
    Params p{};
    const float** pp = (const float**)&p;
    for (int i = 0; i < 21; ++i) pp[i] = (const float*)d_in[i];
    p.out = (float*)d_out; p.ws = (unsigned char*)d_ws;
    void* args[] = {&p};
    hipError_t e = hipLaunchCooperativeKernel((const void*)fwd_megakernel, dim3(grid), dim3(512), args, LDS_BYTES, stream);
    if (e != hipSuccess) fprintf(stderr, "cooperative launch failed: %s (grid %d)\n", hipGetErrorString(e), grid);
}
```

```cpp
#include <hip/hip_runtime.h>
#include <hip/hip_cooperative_groups.h>
#include <cstdio>
#include <cstdint>
namespace cg = cooperative_groups;

#define LAS __attribute__((address_space(3)))
#define GASX __attribute__((address_space(1)))
typedef unsigned short bf16_t;
typedef short bf16x8 __attribute__((ext_vector_type(8)));
typedef short s16x4 __attribute__((ext_vector_type(4)));
typedef float f32x4 __attribute__((ext_vector_type(4)));
typedef float f32x2 __attribute__((ext_vector_type(2)));
typedef unsigned u32x4 __attribute__((ext_vector_type(4)));
typedef unsigned u32x2 __attribute__((ext_vector_type(2)));

constexpr int XL_OFF = 131072, XL_SZ = 1280;
constexpr int NTOK = 32768, DM = 1024, SEQ = 8192, NLAYER = 4, NIN = 12296, ZW = 7168, FF = 4096, PED = 256;
constexpr float EPS = 1e-6f;
constexpr size_t MiB = 1u << 20;
constexpr size_t WS_W1 = 0, WS_WY = 15 * MiB, WS_WGM = 21 * MiB, WS_WGR = 23 * MiB, WS_WBM = 25 * MiB, WS_WBR = 27 * MiB, WS_WOUT = 31 * MiB,
                 WS_WFF1 = 33 * MiB, WS_WFF2 = 41 * MiB, WS_WPG = 49 * MiB, WS_WPE = 51 * MiB, WS_PB = 52 * MiB, WS_XB0 = 68 * MiB, WS_XB1 = 132 * MiB,
                 WS_MG = 196 * MiB, WS_GATES = 260 * MiB, WS_SS0 = 261 * MiB, WS_SS1 = 263 * MiB, WS_HSTAT = 265 * MiB, WS_ROPE = 281 * MiB, WS_Z = 289 * MiB,
                 WS_GV = 737 * MiB, WS_CTL = 739 * MiB, WS_WY1 = 740 * MiB, WS_WGM1 = 746 * MiB, WS_WGR1 = 748 * MiB, WS_END = 750 * MiB;
constexpr int LDS_BYTES = 155648;

struct Params {
    const float *x, *p, *norm1_g, *w_in, *b_in, *conv_w, *conv_b, *m_norm_g, *r_norm_g, *w_bm, *w_br, *w_out, *norm2_g, *w_ff1, *b_ff1, *w_ff2, *b_ff2,
        *norm3_g, *w_pe_gate, *w_pe, *final_g;
    float* out; unsigned char* ws;
};

__device__ __forceinline__ int lane_id_fresh() { unsigned z = 0u; asm volatile("" : "+v"(z)); return (int)__builtin_amdgcn_mbcnt_hi(~0u, __builtin_amdgcn_mbcnt_lo(~0u, z)); }
__device__ __forceinline__ unsigned cvt_pk_bf16(float lo, float hi) { unsigned r; asm volatile("v_cvt_pk_bf16_f32 %0, %1, %2" : "=v"(r) : "v"(lo), "v"(hi)); return r; }
__device__ __forceinline__ float bflo(unsigned u) { return __uint_as_float(u << 16); }
__device__ __forceinline__ float bfhi(unsigned u) { return __uint_as_float(u & 0xffff0000u); }
__device__ __forceinline__ float fma_s(float a, float b, float c) { float r; asm volatile("v_fma_f32 %0, %1, %2, %3" : "=v"(r) : "v"(a), "v"(b), "v"(c)); return r; }
__device__ __forceinline__ float mul_s(float a, float b) { float r; asm volatile("v_mul_f32_e32 %0, %1, %2" : "=v"(r) : "v"(a), "v"(b)); return r; }
__device__ __forceinline__ float add_s(float a, float b) { float r; asm volatile("v_add_f32_e32 %0, %1, %2" : "=v"(r) : "v"(a), "v"(b)); return r; }
__device__ __forceinline__ float sub_s(float a, float b) { float r; asm volatile("v_sub_f32_e32 %0, %1, %2" : "=v"(r) : "v"(a), "v"(b)); return r; }
__device__ __forceinline__ float relu_s(float a) { float r; asm volatile("v_max_f32_e32 %0, 0, %1" : "=v"(r) : "v"(a)); return r; }
__device__ __forceinline__ f32x4 fma4s(f32x4 a, float s, f32x4 c) { return (f32x4){fma_s(a[0], s, c[0]), fma_s(a[1], s, c[1]), fma_s(a[2], s, c[2]), fma_s(a[3], s, c[3])}; }
__device__ __forceinline__ f32x4 fma4(f32x4 a, f32x4 b, f32x4 c) { return (f32x4){fma_s(a[0], b[0], c[0]), fma_s(a[1], b[1], c[1]), fma_s(a[2], b[2], c[2]), fma_s(a[3], b[3], c[3])}; }
__device__ __forceinline__ f32x4 mul4(f32x4 a, f32x4 b) { return (f32x4){mul_s(a[0], b[0]), mul_s(a[1], b[1]), mul_s(a[2], b[2]), mul_s(a[3], b[3])}; }
__device__ __forceinline__ f32x4 mul4s(f32x4 a, float s) { return (f32x4){mul_s(a[0], s), mul_s(a[1], s), mul_s(a[2], s), mul_s(a[3], s)}; }
__device__ __forceinline__ f32x4 add4(f32x4 a, f32x4 b) { return (f32x4){add_s(a[0], b[0]), add_s(a[1], b[1]), add_s(a[2], b[2]), add_s(a[3], b[3])}; }
__device__ __forceinline__ f32x4 sub4s(f32x4 a, float s) { return (f32x4){sub_s(a[0], s), sub_s(a[1], s), sub_s(a[2], s), sub_s(a[3], s)}; }
__device__ __forceinline__ f32x4 relu4(f32x4 a) { return (f32x4){relu_s(a[0]), relu_s(a[1]), relu_s(a[2]), relu_s(a[3])}; }
__device__ __forceinline__ float sigmoidf_(float v) { float r = __builtin_amdgcn_rcpf(1.f + __expf(-v)); asm volatile("s_nop 1" : "+v"(r)); return r; }
__device__ __forceinline__ f32x4 sigmoid4(f32x4 v) { return (f32x4){sigmoidf_(v[0]), sigmoidf_(v[1]), sigmoidf_(v[2]), sigmoidf_(v[3])}; }
__device__ __forceinline__ u32x2 pack4(f32x4 v) { u32x2 w; w.x = cvt_pk_bf16(v[0], v[1]); w.y = cvt_pk_bf16(v[2], v[3]); return w; }
__device__ __forceinline__ u32x4 pack8(f32x4 a, f32x4 b) { u32x4 w; w.x = cvt_pk_bf16(a[0], a[1]); w.y = cvt_pk_bf16(a[2], a[3]); w.z = cvt_pk_bf16(b[0], b[1]); w.w = cvt_pk_bf16(b[2], b[3]); return w; }
#define LDS_WAIT() asm volatile("s_waitcnt lgkmcnt(0)" ::: "memory")

constexpr int BM = 256, BK = 64, HALF = 128, HTB = HALF * BK * 2, STAGE_BYTES = 8 * HTB, NXCD = 8, WGM = 8;
__device__ __forceinline__ int lds_byte(int r, int c) { const int st = (r >> 4) * 2 + (c >> 5), rr = r & 15, cc = c & 31, ob = rr * 64 + cc * 2; return st * 1024 + (ob ^ (((ob >> 9) & 1) << 5)); }
__device__ __forceinline__ int perm32(int rho) { const int n = rho >> 4, i = rho & 15; return 8 * (i >> 2) + 4 * n + (i & 3); }
__device__ __forceinline__ void stage_rc(int b, int& R, int& C) { const int st = b / 1024, sb = b % 1024, swz = sb ^ (((sb >> 9) & 1) << 5); R = (st >> 1) * 16 + swz / 64; C = (st & 1) * 32 + (swz % 64) / 2; }

struct UnitD { const char* A; const char* B; unsigned lda, ldb; int nt, pm, pn, sub; };
struct SubG { const char* A; const char* B; unsigned lda, ldb; int nt; };
struct TileOrder {
    int nM, nN, nwg, G, c;
    __device__ void init(int M, int N, int G_, int c_) { nM = M / BM; nN = N / BM; nwg = nM * nN; G = G_; c = c_; }
    __device__ bool tile(int i, int& pm, int& pn) const {
        const long L = (long)i * G + c; if (L >= nwg) return false;
        int wgid = (int)L; { const int q = nwg / NXCD, r = nwg % NXCD, xcd = wgid % NXCD, off = wgid / NXCD; wgid = (xcd < r ? xcd * (q + 1) : r * (q + 1) + (xcd - r) * q) + off; }
        const int nig = WGM * nN, gid = wgid / nig, fm = gid * WGM, gsz = (nM - fm) < WGM ? (nM - fm) : WGM;
        pm = fm + ((wgid % nig) % gsz); pn = (wgid % nig) / gsz; return true;
    }
};
template <int NSUB> struct Sched {
    TileOrder T; SubG g0, g1, g2, g3;
    __device__ __forceinline__ bool next(int ui, UnitD& u) const {
        const int round = ui / NSUB, sub = ui % NSUB; int pm, pn;
        if (!T.tile(round, pm, pn)) return false;
        const char* gA = g0.A; const char* gB = g0.B; unsigned glda = g0.lda, gldb = g0.ldb; int gnt = g0.nt;
        if (NSUB > 1) { const bool s1 = sub == 1; gA = s1 ? g1.A : gA; gB = s1 ? g1.B : gB; glda = s1 ? g1.lda : glda; gldb = s1 ? g1.ldb : gldb; gnt = s1 ? g1.nt : gnt; }
        if (NSUB > 2) { const bool s2 = sub == 2; gA = s2 ? g2.A : gA; gB = s2 ? g2.B : gB; glda = s2 ? g2.lda : glda; gldb = s2 ? g2.ldb : gldb; gnt = s2 ? g2.nt : gnt; }
        if (NSUB > 3) { const bool s3 = sub == 3; gA = s3 ? g3.A : gA; gB = s3 ? g3.B : gB; glda = s3 ? g3.lda : glda; gldb = s3 ? g3.ldb : gldb; gnt = s3 ? g3.nt : gnt; }
        u.A = gA + (size_t)pm * BM * glda; u.B = gB + (size_t)pn * BM * gldb; u.lda = glda; u.ldb = gldb; u.nt = gnt; u.pm = pm; u.pn = pn; u.sub = sub; return true;
    }
};

template <class Epi, class SchedT>
__device__ __forceinline__ void gemm_phase(LAS unsigned char* lds, const SchedT& S, const Epi& E, const int tid) {
    const int wid = __builtin_amdgcn_readfirstlane(tid >> 6), lane = tid & 63, wr = wid >> 2, wc = wid & 3, fr = lane & 15, fq = lane >> 4;
    int sR0, sC0, sR1, sC1; stage_rc(tid * 16, sR0, sC0); stage_rc(tid * 16 + 8192, sR1, sC1);
    UnitD cur, nxt; int ui = 0;
    if (!S.next(0, cur)) return;
    LAS float* xl = (LAS float*)(lds + XL_OFF);
#define PRE_TID() (wid * 64 + lane_id_fresh())
    E.pre(cur, PRE_TID(), xl);
    const unsigned sRr[2] = {(unsigned)sR0, (unsigned)sR1}, sCc[2] = {(unsigned)sC0 * 2u, (unsigned)sC1 * 2u};
    const unsigned sRb[2] = {(unsigned)((sR0 & ~31) + perm32(sR0 & 31)), (unsigned)((sR1 & ~31) + perm32(sR1 & 31))};
    const size_t kstep = (size_t)(BK * 2);
    const unsigned ldsw = (unsigned)wid * 1024u;
    const int aoff = lds_byte(wr * 64 + fr, fq * 8), boff = lds_byte(wc * 32 + fr, fq * 8);
#define PG8_SA(b, h) (((b) * 2 + (h)) * HTB)
#define PG8_SB(b, h) ((4 + (b) * 2 + (h)) * HTB)
#define PG8_STAGE_(bufoff, gbase, ld, RR) do { _Pragma("unroll") for (int _i = 0; _i < 2; ++_i) \
        __builtin_amdgcn_global_load_lds((const unsigned*)((const char*)(gbase) + (RR[_i] * (ld) + sCc[_i])), (LAS unsigned*)(lds + (bufoff) + ldsw + _i * 8192), 16, 0, 0); } while (0)
#define PG8_STAGE(bufoff, gbase, ld) PG8_STAGE_(bufoff, gbase, ld, sRr)
#define PG8_STAGEB(bufoff, gbase, ld) PG8_STAGE_(bufoff, gbase, ld, sRb)
#define PG8_LDA(dst, b, h) do { _Pragma("unroll") for (int m = 0; m < 4; ++m) _Pragma("unroll") for (int k = 0; k < 2; ++k) dst[m][k] = *(const LAS bf16x8*)(lds + PG8_SA(b, h) + aoff + m * 2048 + k * 1024); } while (0)
#define PG8_LDB(dst, b, h) do { _Pragma("unroll") for (int n = 0; n < 2; ++n) _Pragma("unroll") for (int k = 0; k < 2; ++k) dst[n][k] = *(const LAS bf16x8*)(lds + PG8_SB(b, h) + boff + n * 2048 + k * 1024); } while (0)
#define PG8_MMA(ai, bj, At, Bt) do { __builtin_amdgcn_s_setprio(1); _Pragma("unroll") for (int m = 0; m < 4; ++m) _Pragma("unroll") for (int n = 0; n < 2; ++n) _Pragma("unroll") for (int k = 0; k < 2; ++k) \
        acc[ai][bj][m][n] = __builtin_amdgcn_mfma_f32_16x16x32_bf16(Bt[n][k], At[m][k], acc[ai][bj][m][n], 0, 0, 0); __builtin_amdgcn_s_setprio(0); } while (0)
#define PG8_WAIT_V(n) asm volatile("s_waitcnt vmcnt(" #n ")" ::: "memory")
#define PG8_WAIT_L(n) asm volatile("s_waitcnt lgkmcnt(" #n ")" ::: "memory")
#define PG8_WAIT_VX() PG8_WAIT_V(8)
#define PG8_BAR __builtin_amdgcn_s_barrier()
#define PG8_SCHED __builtin_amdgcn_sched_barrier(0)
    f32x4 acc[2][2][4][2];
#pragma unroll
    for (int a = 0; a < 2; ++a)
#pragma unroll
        for (int b = 0; b < 2; ++b)
#pragma unroll
            for (int m = 0; m < 4; ++m)
#pragma unroll
                for (int n = 0; n < 2; ++n) acc[a][b][m][n] = (f32x4){0.f, 0.f, 0.f, 0.f};
    bf16x8 At[4][2], B0[2][2], B1[2][2];
    const char* cA = cur.A; const char* cB = cur.B;
    {
        const size_t hA = (size_t)HALF * cur.lda, hB = (size_t)HALF * cur.ldb;
        PG8_STAGEB(PG8_SB(0, 0), cB, cur.ldb); PG8_STAGEB(PG8_SB(0, 1), cB + hB, cur.ldb); PG8_STAGE(PG8_SA(0, 0), cA, cur.lda); PG8_STAGE(PG8_SA(0, 1), cA + hA, cur.lda);
        if (wr == 1) PG8_BAR;
        PG8_WAIT_V(2); PG8_BAR;
        PG8_STAGEB(PG8_SB(1, 0), cB + kstep, cur.ldb); PG8_STAGE(PG8_SA(1, 0), cA + kstep, cur.lda); PG8_STAGEB(PG8_SB(1, 1), cB + hB + kstep, cur.ldb);
        PG8_WAIT_V(6); PG8_BAR;
    }
    for (;;) {
        const bool has_next = S.next(ui + 1, nxt);
        const char* nA = has_next ? nxt.A : cA; const char* nB = has_next ? nxt.B : cB;
        const unsigned nlda = has_next ? nxt.lda : cur.lda, nldb = has_next ? nxt.ldb : cur.ldb;
        const size_t hA = (size_t)HALF * cur.lda, hB = (size_t)HALF * cur.ldb, nhA = (size_t)HALF * nlda, nhB = (size_t)HALF * nldb;
        const int nt = cur.nt;
        for (int t = 0; t < nt; t += 2) {
            const bool last = (t == nt - 2);
            const char* a1 = cA + (size_t)(t + 1) * kstep;
            const char* a2 = last ? nA : cA + (size_t)(t + 2) * kstep; const char* b2 = last ? nB : cB + (size_t)(t + 2) * kstep;
            const char* a3 = a2 + kstep; const char* b3 = b2 + kstep;
            const unsigned la2 = last ? nlda : cur.lda, lb2 = last ? nldb : cur.ldb;
            const size_t ha2 = last ? nhA : hA, hb2 = last ? nhB : hB;
            PG8_LDB(B0, 0, 0); PG8_LDB(B1, 0, 1); PG8_SCHED; PG8_LDA(At, 0, 0); PG8_STAGE(PG8_SA(1, 1), a1 + hA, cur.lda);
            PG8_WAIT_VX(); PG8_WAIT_L(0); PG8_BAR; PG8_MMA(0, 0, At, B0); PG8_MMA(0, 1, At, B1); PG8_BAR; PG8_SCHED;
            PG8_LDA(At, 0, 1); PG8_STAGEB(PG8_SB(0, 0), b2, lb2); PG8_STAGEB(PG8_SB(0, 1), b2 + hb2, lb2); PG8_STAGE(PG8_SA(0, 0), a2, la2);
            PG8_WAIT_VX(); PG8_WAIT_L(0); PG8_BAR; PG8_MMA(1, 0, At, B0); PG8_MMA(1, 1, At, B1); PG8_BAR; PG8_SCHED;
            PG8_LDB(B0, 1, 0); PG8_LDB(B1, 1, 1); PG8_SCHED; PG8_LDA(At, 1, 0); PG8_STAGE(PG8_SA(0, 1), a2 + ha2, la2);
            PG8_WAIT_VX(); PG8_WAIT_L(0); PG8_BAR; PG8_MMA(0, 0, At, B0); PG8_MMA(0, 1, At, B1); PG8_BAR; PG8_SCHED;
            PG8_LDA(At, 1, 1); PG8_STAGEB(PG8_SB(1, 0), b3, lb2); PG8_STAGEB(PG8_SB(1, 1), b3 + hb2, lb2); PG8_STAGE(PG8_SA(1, 0), a3, la2);
            PG8_WAIT_V(8); PG8_WAIT_L(0); PG8_BAR; PG8_MMA(1, 0, At, B0); PG8_MMA(1, 1, At, B1); PG8_BAR; PG8_SCHED;
        }
        if (wr == 0) PG8_BAR;
        asm volatile("s_nop 15\n\ts_nop 7" ::: "memory");
        (void)E(acc, cur, wr, wc, fr, fq, xl + (ui & 1) * XL_SZ);
        if (has_next) E.pre(nxt, PRE_TID(), xl + ((ui + 1) & 1) * XL_SZ);
        if (!has_next) break;
#pragma unroll
        for (int a = 0; a < 2; ++a)
#pragma unroll
            for (int b = 0; b < 2; ++b)
#pragma unroll
                for (int m = 0; m < 4; ++m)
#pragma unroll
                    for (int n = 0; n < 2; ++n) acc[a][b][m][n] = (f32x4){0.f, 0.f, 0.f, 0.f};
        cur = nxt; cA = nA; cB = nB; ++ui;
        if (wr == 1) PG8_BAR;
    }
    PG8_WAIT_V(0);
    PG8_BAR;
#undef PG8_SA
#undef PG8_SB
#undef PG8_STAGE
#undef PG8_STAGEB
#undef PG8_STAGE_
#undef PG8_LDA
#undef PG8_LDB
#undef PG8_MMA
#undef PG8_WAIT_V
#undef PG8_WAIT_L
#undef PG8_WAIT_VX
#undef PG8_BAR
#undef PG8_SCHED
}

typedef f32x4 AccT[2][2][4][2];
#define ROW(ai, m) (u.pm * BM + (ai) * HALF + wr * 64 + (m) * 16 + fr)
#define COL(bj, n) (u.pn * BM + (bj) * HALF + wc * 32 + fq * 8 + (n) * 4)
#define FOR_AI _Pragma("unroll") for (int ai = 0; ai < 2; ++ai)
#define FOR_M _Pragma("unroll") for (int m = 0; m < 4; ++m)
#define FOR_BJ _Pragma("unroll") for (int bj = 0; bj < 2; ++bj)
#define FOR_N _Pragma("unroll") for (int n = 0; n < 2; ++n)
__device__ __forceinline__ void rows_rstd(const float* ss, const UnitD& u, int wr, int fr, int fq, float (&rs)[2][4]) {
    f32x4 v[2][4];
    FOR_AI FOR_M v[ai][m] = *(const f32x4*)(ss + (size_t)ROW(ai, m) * 16 + fq * 4);
    float t[2][4], e[2][4];
    FOR_AI FOR_M t[ai][m] = (v[ai][m][0] + v[ai][m][1]) + (v[ai][m][2] + v[ai][m][3]);
    FOR_AI FOR_M e[ai][m] = __shfl_xor(t[ai][m], 16);
    FOR_AI FOR_M t[ai][m] += e[ai][m];
    FOR_AI FOR_M e[ai][m] = __shfl_xor(t[ai][m], 32);
    FOR_AI FOR_M rs[ai][m] = rsqrtf((t[ai][m] + e[ai][m]) * (1.f / DM) + EPS);
}

__device__ __forceinline__ void pre_rstd(const float* ss, const UnitD& nu, int tid, LAS float* xb) {
    const float* sp = ss + (size_t)(nu.pm * BM + (tid >> 1)) * 16 + (tid & 1) * 8;
    const f32x4 t = *(const f32x4*)sp + *(const f32x4*)(sp + 4);
    float s = (t[0] + t[1]) + (t[2] + t[3]);
    s += __shfl_xor(s, 1);
    if ((tid & 1) == 0) xb[tid >> 1] = rsqrtf(s * (1.f / DM) + EPS);
}
__device__ __forceinline__ void pre_vec(const float* src, int tid, LAS float* dst) { if (tid < 64) *(LAS f32x4*)(dst + tid * 4) = *(const f32x4*)(src + tid * 4); }
#define XB_RS(ai, m) xb[(ai) * HALF + wr * 64 + (m) * 16 + fr]
#define XB_MU(ai, m) xb[256 + (ai) * HALF + wr * 64 + (m) * 16 + fr]
#define XB_HR(ai, m) xb[512 + (ai) * HALF + wr * 64 + (m) * 16 + fr]
#define XB_BI(bj, n) (*(const LAS f32x4*)(xb + 768 + (bj) * HALF + wc * 32 + fq * 8 + (n) * 4))
#define XB_GN(bj, n) (*(const LAS f32x4*)(xb + 1024 + (bj) * HALF + wc * 32 + fq * 8 + (n) * 4))

__device__ __forceinline__ void unpack8(const u32x4 w, f32x4& a, f32x4& b) { a = (f32x4){bflo(w.x), bfhi(w.x), bflo(w.y), bfhi(w.y)}; b = (f32x4){bflo(w.z), bfhi(w.z), bflo(w.w), bfhi(w.w)}; }
template <bool BIAS, bool GATED>
__device__ __forceinline__ int x_update(const AccT& acc, const UnitD& u, int wr, int wc, int fr, int fq, const bf16_t* xin, bf16_t* xout, float* ss, const float* bias, const bf16_t* gate) {
    f32x4 bv[2][2];
    FOR_BJ FOR_N bv[bj][n] = BIAS ? *(const f32x4*)(bias + COL(bj, n)) : (f32x4){0.f, 0.f, 0.f, 0.f};
    FOR_AI {
#pragma unroll
      for (int mh = 0; mh < 2; ++mh) {
        u32x4 xv[4][2], gv[4][2];
#pragma unroll
        for (int m = mh * 2; m < mh * 2 + 2; ++m) FOR_BJ {
            const size_t o = (size_t)ROW(ai, m) * DM + COL(bj, 0);
            xv[m][bj] = *(const u32x4*)(xin + o);
            if (GATED) gv[m][bj] = *(const u32x4*)(gate + o);
        }
#pragma unroll
        for (int m = mh * 2; m < mh * 2 + 2; ++m) {
            const int row = ROW(ai, m);
            float part = 0.f;
            FOR_BJ {
                f32x4 x0, x1; unpack8(xv[m][bj], x0, x1);
                f32x4 a0 = acc[ai][bj][m][0], a1 = acc[ai][bj][m][1];
                f32x4 r0, r1;
                if (GATED) { f32x4 g0, g1; unpack8(gv[m][bj], g0, g1); r0 = fma4(a0, g0, x0); r1 = fma4(a1, g1, x1); }
                else { r0 = add4(x0, a0); r1 = add4(x1, a1); }
                if (BIAS) { r0 = add4(r0, bv[bj][0]); r1 = add4(r1, bv[bj][1]); }
#pragma unroll
                for (int e = 0; e < 4; ++e) { part = fma_s(r0[e], r0[e], part); part = fma_s(r1[e], r1[e], part); }
                *(u32x4*)(xout + (size_t)row * DM + COL(bj, 0)) = pack8(r0, r1);
            }
            part += __shfl_xor(part, 16); part += __shfl_xor(part, 32);
            if (fq == 0) ss[(size_t)row * 16 + u.pn * 4 + wc] = part;
        }
        asm volatile("" ::: "memory");
      }
    }
    return 16;
}

struct EpiIn {
    const float* ss; const float* bin; bf16_t* Z; float* gates; const float* ropec;
    __device__ __forceinline__ void pre(const UnitD& nu, int tid, LAS float* xb) const {
        pre_rstd(ss, nu, tid, xb);
        if (tid < 64) { const int c = tid * 4, col = nu.pn * BM + c;
            const f32x4 b = (nu.pn < 28) ? *(const f32x4*)(bin + (col < 3072 ? col : col + 1032)) : (c < 8 ? *(const f32x4*)(bin + 4096 + c) : (f32x4){0.f, 0.f, 0.f, 0.f});
            *(LAS f32x4*)(xb + 768 + c) = b; }
    }
    __device__ __forceinline__ int operator()(const AccT& acc, const UnitD& u, int wr, int wc, int fr, int fq, const LAS float* xb) const {
        f32x4 bv[2][2];
        FOR_BJ FOR_N bv[bj][n] = XB_BI(bj, n);
        float rs[2][4];
        FOR_AI FOR_M rs[ai][m] = XB_RS(ai, m);
        if (u.pn < 28) {
            if (u.pn >= 12 && u.pn < 20) {
                const float sc = u.pn >= 16 ? 0.0625f : 1.f;
                const float* ropes = ropec + (size_t)SEQ * 128;
                FOR_AI {
#pragma unroll
                    for (int mh = 0; mh < 2; ++mh) {
                        f32x4 cv[2][2], sv[2][2];
#pragma unroll
                        for (int mm = 0; mm < 2; ++mm) FOR_N { const size_t o = (size_t)(ROW(ai, mh * 2 + mm) & (SEQ - 1)) * 128 + wc * 32 + fq * 8 + n * 4; cv[mm][n] = *(const f32x4*)(ropec + o); sv[mm][n] = *(const f32x4*)(ropes + o); }
#pragma unroll
                        for (int mm = 0; mm < 2; ++mm) {
                            const int m = mh * 2 + mm;
                            f32x4 o1[2], o2[2];
                            FOR_N {
                                const f32x4 x1 = mul4s(fma4s(acc[ai][0][m][n], rs[ai][m], bv[0][n]), sc), x2 = mul4s(fma4s(acc[ai][1][m][n], rs[ai][m], bv[1][n]), sc);
#pragma unroll
                                for (int e = 0; e < 4; ++e) { o1[n][e] = fma_s(x1[e], cv[mm][n][e], -mul_s(x2[e], sv[mm][n][e])); o2[n][e] = fma_s(x1[e], sv[mm][n][e], mul_s(x2[e], cv[mm][n][e])); }
                            }
                            bf16_t* zr = Z + (size_t)ROW(ai, m) * ZW;
                            *(u32x4*)(zr + COL(0, 0)) = pack8(o1[0], o1[1]);
                            *(u32x4*)(zr + COL(1, 0)) = pack8(o2[0], o2[1]);
                        }
                        asm volatile("" ::: "memory");
                    }
                }
            } else {
                FOR_AI FOR_M FOR_BJ *(u32x4*)(Z + (size_t)ROW(ai, m) * ZW + COL(bj, 0)) = pack8(fma4s(acc[ai][bj][m][0], rs[ai][m], bv[bj][0]), fma4s(acc[ai][bj][m][1], rs[ai][m], bv[bj][1]));
            }
            return 16;
        } else {
            const f32x4 b0 = bv[0][0], b1 = bv[0][1];
            if (wc == 0 && fq == 0) { FOR_AI FOR_M { float* gp = gates + (size_t)ROW(ai, m) * 8; *(f32x4*)gp = fma4s(acc[ai][0][m][0], rs[ai][m], b0); *(f32x4*)(gp + 4) = fma4s(acc[ai][0][m][1], rs[ai][m], b1); } }
            return 0;
        }
    }
};
struct EpiY {
    const float* ss; const float* bin; bf16_t* Z; const float* hstat; const float* mg; const float* rg;
    __device__ __forceinline__ void pre(const UnitD& nu, int tid, LAS float* xb) const {
        pre_rstd(ss, nu, tid, xb);
        const bool isM = nu.pn < 4; const int hidx = isM ? nu.pn : 4 + ((nu.pn - 4) >> 1);
        const float invw = __builtin_bit_cast(float, __builtin_amdgcn_readfirstlane(isM ? 0x3b800000 : 0x3b000000));
        const float* hp = hstat + ((size_t)(nu.pm * BM + (tid >> 1)) * 8 + hidx) * 16 + (tid & 1) * 8;
        f32x4 t = (f32x4){0.f, 0.f, 0.f, 0.f};
        if (!(isM && (tid & 1))) t = *(const f32x4*)hp + *(const f32x4*)(hp + 4);
        float sm = t[0] + t[2], q = t[1] + t[3];
        sm += __shfl_xor(sm, 1); q += __shfl_xor(q, 1);
        if ((tid & 1) == 0) { const float mu = sm * invw; xb[256 + (tid >> 1)] = mu; xb[512 + (tid >> 1)] = rsqrtf(fmaxf(q * invw - mu * mu, 0.f) + EPS); }
        pre_vec(bin + (isM ? 3072 : 7176) + nu.pn * BM, tid, xb + 768);
        pre_vec((isM ? mg : rg - 1024) + nu.pn * BM, tid, xb + 1024);
    }
    __device__ __forceinline__ int operator()(const AccT& acc, const UnitD& u, int wr, int wc, int fr, int fq, const LAS float* xb) const {
        const bool isM = u.pn < 4;
        FOR_AI {
            float rs[4], mu[4], hr[4];
            FOR_M { rs[m] = XB_RS(ai, m); mu[m] = XB_MU(ai, m); hr[m] = XB_HR(ai, m); }
            FOR_M {
                u32x4 hv[2];
                FOR_BJ { const int col = COL(bj, 0); hv[bj] = *(const u32x4*)(Z + (size_t)ROW(ai, m) * ZW + (isM ? 2048 + col : col + 4096)); }
                FOR_BJ {
                    const int col = COL(bj, 0);
                    const u32x4 w = hv[bj];
                    f32x4 hh[2];
                    FOR_N {
                        const f32x4 g = fma4s(acc[ai][bj][m][n], rs[m], XB_BI(bj, n));
                        f32x4 gate = sigmoid4(g);
                        if (!isM) gate = mul4(gate, g);
                        const unsigned w0 = n ? w.z : w.x, w1 = n ? w.w : w.y;
                        const f32x4 h = (f32x4){bflo(w0), bfhi(w0), bflo(w1), bfhi(w1)};
                        hh[n] = mul4(mul4(mul4s(sub4s(h, mu[m]), hr[m]), XB_GN(bj, n)), gate);
                    }
                    *(u32x4*)(Z + (size_t)ROW(ai, m) * ZW + (isM ? 2048 + col : col + 4096)) = pack8(hh[0], hh[1]);
                }
                asm volatile("" ::: "memory");
            }
        }
        return 16;
    }
};
struct EpiMerge {
    const float* ss; const float* bin; bf16_t* Z; bf16_t* MG; int sub0;
    __device__ __forceinline__ void pre(const UnitD& nu, int tid, LAS float* xb) const {
        const int sub = nu.sub + sub0;
        if (sub == 0 || sub == 2) { pre_rstd(ss, nu, tid, xb); pre_vec(bin + (sub == 0 ? 10248 : 11272) + nu.pn * BM, tid, xb + 768); }
    }
    __device__ __forceinline__ int operator()(const AccT& acc, const UnitD& u, int wr, int wc, int fr, int fq, const LAS float* xb) const {
        const int sub = u.sub + sub0;
        if (sub == 0 || sub == 2) {
            const int toff = (sub == 0) ? 0 : 1024;
            f32x4 bv[2][2];
            FOR_BJ FOR_N bv[bj][n] = XB_BI(bj, n);
            float rs[2][4];
            FOR_AI FOR_M rs[ai][m] = XB_RS(ai, m);
            FOR_AI FOR_M FOR_BJ *(u32x4*)(Z + (size_t)ROW(ai, m) * ZW + toff + COL(bj, 0)) = pack8(sigmoid4(fma4s(acc[ai][bj][m][0], rs[ai][m], bv[bj][0])), sigmoid4(fma4s(acc[ai][bj][m][1], rs[ai][m], bv[bj][1])));
        } else if (sub == 1) {
            FOR_AI {
#pragma unroll
                for (int mh = 0; mh < 2; ++mh) {
                    u32x4 tv[2][2];
#pragma unroll
                    for (int mm = 0; mm < 2; ++mm) FOR_BJ tv[mm][bj] = *(const u32x4*)(Z + (size_t)ROW(ai, mh * 2 + mm) * ZW + COL(bj, 0));
#pragma unroll
                    for (int mm = 0; mm < 2; ++mm) FOR_BJ { const int m = mh * 2 + mm; f32x4 t0, t1; unpack8(tv[mm][bj], t0, t1); *(u32x4*)(Z + (size_t)ROW(ai, m) * ZW + COL(bj, 0)) = pack8(mul4(t0, acc[ai][bj][m][0]), mul4(t1, acc[ai][bj][m][1])); }
                    asm volatile("" ::: "memory");
                }
            }
        } else {
            FOR_AI {
#pragma unroll
                for (int mh = 0; mh < 2; ++mh) {
                    u32x4 ta[2][2], tb[2][2];
#pragma unroll
                    for (int mm = 0; mm < 2; ++mm) FOR_BJ { const bf16_t* zr = Z + (size_t)ROW(ai, mh * 2 + mm) * ZW + COL(bj, 0); ta[mm][bj] = *(const u32x4*)zr; tb[mm][bj] = *(const u32x4*)(zr + 1024); }
#pragma unroll
                    for (int mm = 0; mm < 2; ++mm) FOR_BJ {
                        const int m = mh * 2 + mm;
                        f32x4 a0, a1, b0, b1; unpack8(ta[mm][bj], a0, a1); unpack8(tb[mm][bj], b0, b1);
                        *(u32x4*)(MG + (size_t)ROW(ai, m) * DM + COL(bj, 0)) = pack8(fma4(b0, acc[ai][bj][m][0], a0), fma4(b1, acc[ai][bj][m][1], a1));
                    }
                    asm volatile("" ::: "memory");
                }
            }
        }
        return 16;
    }
};
struct EpiX {
    const bf16_t* xin; bf16_t* xout; float* ss; const float* bias;
    __device__ __forceinline__ void pre(const UnitD&, int, LAS float*) const {}
    __device__ __forceinline__ int operator()(const AccT& acc, const UnitD& u, int wr, int wc, int fr, int fq, const LAS float* xb) const {
        if (bias) return x_update<true, false>(acc, u, wr, wc, fr, fq, xin, xout, ss, bias, nullptr);
        return x_update<false, false>(acc, u, wr, wc, fr, fq, xin, xout, ss, nullptr, nullptr);
    }
};
struct EpiFF1 {
    const float* ss; const float* b1; bf16_t* H;
    __device__ __forceinline__ void pre(const UnitD& nu, int tid, LAS float* xb) const { pre_rstd(ss, nu, tid, xb); pre_vec(b1 + nu.pn * BM, tid, xb + 768); }
    __device__ __forceinline__ int operator()(const AccT& acc, const UnitD& u, int wr, int wc, int fr, int fq, const LAS float* xb) const {
        f32x4 bv[2][2];
        FOR_BJ FOR_N bv[bj][n] = XB_BI(bj, n);
        float rs[2][4];
        FOR_AI FOR_M rs[ai][m] = XB_RS(ai, m);
        FOR_AI FOR_M FOR_BJ {
            f32x4 vv[2];
            FOR_N {
                const f32x4 v = relu4(fma4s(acc[ai][bj][m][n], rs[ai][m], bv[bj][n]));
                vv[n] = mul4(v, v);
            }
            *(u32x4*)(H + (size_t)ROW(ai, m) * FF + COL(bj, 0)) = pack8(vv[0], vv[1]);
        }
        return 16;
    }
};
struct EpiPE {
    const float* ssr; bf16_t* T; const bf16_t* xin; bf16_t* xout; float* ssw;
    __device__ __forceinline__ void pre(const UnitD& nu, int tid, LAS float* xb) const { if (nu.sub == 0) pre_rstd(ssr, nu, tid, xb); }
    __device__ __forceinline__ int operator()(const AccT& acc, const UnitD& u, int wr, int wc, int fr, int fq, const LAS float* xb) const {
        if (u.sub == 0) {
            float rs[2][4];
            FOR_AI FOR_M rs[ai][m] = XB_RS(ai, m);
            FOR_AI FOR_M FOR_BJ *(u32x4*)(T + (size_t)ROW(ai, m) * DM + COL(bj, 0)) = pack8(sigmoid4(mul4s(acc[ai][bj][m][0], rs[ai][m])), sigmoid4(mul4s(acc[ai][bj][m][1], rs[ai][m])));
            return 16;
        }
        return x_update<false, true>(acc, u, wr, wc, fr, fq, xin, xout, ssw, nullptr, T);
    }
};

__device__ __forceinline__ void tr_item(const float* W, int ldw, int col0, const float* gs, int K, bf16_t* WT, int nrow0, LAS float* scr, int kb, int lane, int nvalid) {
    const int k0 = 64 * kb;
#pragma unroll 8
    for (int i = 0; i < 32; ++i) {
        const int kk = 2 * i + (lane >> 5), n = lane & 31;
        float v = (n < nvalid) ? W[(size_t)(k0 + kk) * ldw + col0 + n] : 0.f;
        if (gs) v *= gs[k0 + kk];
        scr[kk * 33 + n] = v;
    }
    LDS_WAIT(); asm volatile("" ::: "memory");
    const int c = lane & 7;
#pragma unroll
    for (int j = 0; j < 4; ++j) {
        const int n = (lane >> 3) + 8 * j; const LAS float* s = scr + (8 * c) * 33 + n;
        u32x4 o; o.x = cvt_pk_bf16(s[0 * 33], s[1 * 33]); o.y = cvt_pk_bf16(s[2 * 33], s[3 * 33]); o.z = cvt_pk_bf16(s[4 * 33], s[5 * 33]); o.w = cvt_pk_bf16(s[6 * 33], s[7 * 33]);
        *(u32x4*)(WT + (size_t)(nrow0 + n) * K + k0 + 8 * c) = o;
    }
    LDS_WAIT(); asm volatile("" ::: "memory");
}

__device__ __forceinline__ void prep_phase(const Params& P, int l, int grp, bf16_t* WY, bf16_t* WGM, bf16_t* WGR, LAS unsigned char* lds, int gwb, int NGW, const int tid) {
    const int lane = tid & 63, wave = __builtin_amdgcn_readfirstlane(tid >> 6);
    const int gw = gwb + wave;
    LAS float* scr = (LAS float*)(lds + wave * 16384);
    unsigned char* ws = P.ws;
    bf16_t* W1 = (bf16_t*)(ws + WS_W1);
    bf16_t* WBM = (bf16_t*)(ws + WS_WBM); bf16_t* WBR = (bf16_t*)(ws + WS_WBR); bf16_t* WOUT = (bf16_t*)(ws + WS_WOUT); bf16_t* WFF1 = (bf16_t*)(ws + WS_WFF1);
    bf16_t* WFF2 = (bf16_t*)(ws + WS_WFF2); bf16_t* WPG = (bf16_t*)(ws + WS_WPG); bf16_t* WPE = (bf16_t*)(ws + WS_WPE);
    const float* win = P.w_in + (size_t)l * DM * NIN; const float* g1 = P.norm1_g + l * DM; const float* g2 = P.norm2_g + l * DM; const float* g3 = P.norm3_g + l * DM;
    constexpr int I0 = 16 * 96, I1 = 16 * 128, I2 = 16 * 8, I3 = 16 * 32, I4 = 16 * 64, I5 = 512, I6 = 512, I7 = 512, I8 = 32 * 32, I9 = 512, I10 = 16 * 128, I11 = 64 * 32, I12 = 512, I13 = 4 * 32;
    constexpr int NA = I0 + I1 + I2 + I3 + I4 + I5 + I6, NITEMS = NA + I7 + I8 + I9 + I10 + I11 + I12 + I13;
    const int it_lo = grp == 0 ? 0 : NA, it_hi = grp == 0 ? NA : NITEMS;
    for (int it = it_lo + gw; it < it_hi; it += NGW) {
        int r = it;
        if (r < I0) { const int kb = r / 96, nb = r % 96; tr_item(win, NIN, 32 * nb, g1, DM, W1, 32 * nb, scr, kb, lane, 32); continue; } r -= I0;
        if (r < I1) { const int kb = r / 128, nb = r % 128; tr_item(win, NIN, 4104 + 32 * nb, g1, DM, W1, 3072 + 32 * nb, scr, kb, lane, 32); continue; } r -= I1;
        if (r < I2) { const int kb = r / 8, nb = r % 8; tr_item(win, NIN, 4096, g1, DM, W1, 7168 + 32 * nb, scr, kb, lane, nb == 0 ? 8 : 0); continue; } r -= I2;
        if (r < I3) { const int kb = r / 32, nb = r % 32; tr_item(win, NIN, 3072 + 32 * nb, g1, DM, WY, 32 * nb, scr, kb, lane, 32); continue; } r -= I3;
        if (r < I4) { const int kb = r / 64, nb = r % 64; tr_item(win, NIN, 8200 + 32 * nb, g1, DM, WY, 1024 + 32 * nb, scr, kb, lane, 32); continue; } r -= I4;
        if (r < I5) { const int kb = r / 32, nb = r % 32; tr_item(win, NIN, 10248 + 32 * nb, g1, DM, WGM, 32 * nb, scr, kb, lane, 32); continue; } r -= I5;
        if (r < I6) { const int kb = r / 32, nb = r % 32; tr_item(win, NIN, 11272 + 32 * nb, g1, DM, WGR, 32 * nb, scr, kb, lane, 32); continue; } r -= I6;
        if (r < I7) { const int kb = r / 32, nb = r % 32; tr_item(P.w_bm + (size_t)l * 1024 * DM, DM, 32 * nb, nullptr, 1024, WBM, 32 * nb, scr, kb, lane, 32); continue; } r -= I7;
        if (r < I8) { const int kb = r / 32, nb = r % 32; tr_item(P.w_br + (size_t)l * 2048 * DM, DM, 32 * nb, nullptr, 2048, WBR, 32 * nb, scr, kb, lane, 32); continue; } r -= I8;
        if (r < I9) { const int kb = r / 32, nb = r % 32; tr_item(P.w_out + (size_t)l * DM * DM, DM, 32 * nb, nullptr, DM, WOUT, 32 * nb, scr, kb, lane, 32); continue; } r -= I9;
        if (r < I10) { const int kb = r / 128, nb = r % 128; tr_item(P.w_ff1 + (size_t)l * DM * FF, FF, 32 * nb, g2, DM, WFF1, 32 * nb, scr, kb, lane, 32); continue; } r -= I10;
        if (r < I11) { const int kb = r / 32, nb = r % 32; tr_item(P.w_ff2 + (size_t)l * FF * DM, DM, 32 * nb, nullptr, FF, WFF2, 32 * nb, scr, kb, lane, 32); continue; } r -= I11;
        if (r < I12) { const int kb = r / 32, nb = r % 32; tr_item(P.w_pe_gate + (size_t)l * DM * DM, DM, 32 * nb, g3, DM, WPG, 32 * nb, scr, kb, lane, 32); continue; } r -= I12;
        { const int kb = r / 32, nb = r % 32; tr_item(P.w_pe + (size_t)l * PED * DM, DM, 32 * nb, nullptr, PED, WPE, 32 * nb, scr, kb, lane, 32); }
    }
}

__device__ __forceinline__ void pconv_phase(const Params& P, int l, int gwb, int NGW, const int tid) {
    const int lane = tid & 63, wave = __builtin_amdgcn_readfirstlane(tid >> 6);
    const int gw = gwb + wave;
    unsigned char* ws = P.ws;
    {
        const float* pl = P.p + (size_t)l * NTOK * PED; bf16_t* PB = (bf16_t*)(ws + WS_PB);
        const size_t nchunk = (size_t)NTOK * PED / 8;
        for (size_t i = (size_t)gw * 64 + lane; i < nchunk; i += (size_t)NGW * 64) {
            const f32x4 a = *(const f32x4*)(pl + i * 8), b = *(const f32x4*)(pl + i * 8 + 4);
            u32x4 o; o.x = cvt_pk_bf16(a[0], a[1]); o.y = cvt_pk_bf16(a[2], a[3]); o.z = cvt_pk_bf16(b[0], b[1]); o.w = cvt_pk_bf16(b[2], b[3]);
            *(u32x4*)(PB + i * 8) = o;
        }
    }
}

__device__ __forceinline__ void prep0_phase(const Params& P, int vcu, int G, const int tid) {
    const int lane = tid & 63, wave = __builtin_amdgcn_readfirstlane(tid >> 6);
    const int gw = vcu * 8 + wave, NGW = G * 8;
    unsigned char* ws = P.ws;
    {
        bf16_t* XB = (bf16_t*)(ws + WS_XB0); float* ss = (float*)(ws + WS_SS0);
        for (int row = gw; row < NTOK; row += NGW) {
            const f32x4* xr = (const f32x4*)(P.x + (size_t)row * DM) + lane;
            float s = 0.f;
#pragma unroll
            for (int j = 0; j < 4; ++j) {
                const f32x4 v = xr[64 * j];
                s += (v[0] * v[0] + v[1] * v[1]) + (v[2] * v[2] + v[3] * v[3]);
                *((u32x2*)(XB + (size_t)row * DM) + lane + 64 * j) = pack4(v);
            }
#pragma unroll
            for (int o = 1; o < 64; o <<= 1) s += __shfl_xor(s, o);
            if (lane < 16) ss[(size_t)row * 16 + lane] = (lane == 0) ? s : 0.f;
        }
        float* rc = (float*)(ws + WS_ROPE); float* rsn = rc + (size_t)SEQ * 128;
        for (int i = (vcu * 512 + tid); i < SEQ * 128; i += G * 512) {
            const int pos = i >> 7, j = i & 127;
            const double invf = exp2(-(double)j * (13.287712379549449 / 128.0));
            double ang = (double)pos * invf;
            const double k = rint(ang * 0.15915494309189535);
            ang = ang - k * 6.283185307179586;
            const float af = (float)ang;
            rc[i] = cosf(af); rsn[i] = sinf(af);
        }
    }
}

constexpr int QP = 544, VP = 144, VRP = 208, OBP = 336;
constexpr int S_Q = 0, S_K = 34816, S_ST = 69632, S_VT = 113152, S_VW = 126464, S_P = 139776, S_VEC = 148992;
static_assert(S_K == 64 * QP && S_ST == 2 * 64 * QP && S_VT == S_ST + 80 * QP && S_VW == S_VT + 64 * VRP && S_P == S_VW + 64 * VRP && S_VEC == S_P + 64 * VP && S_VEC + 1024 <= LDS_BYTES - 64, "scan LDS map");
__device__ __forceinline__ s16x4 tr_read(const LAS unsigned char* p) {
    typedef short v4i16_t __attribute__((ext_vector_type(4)));
    return __builtin_bit_cast(s16x4, __builtin_amdgcn_ds_read_tr16_b64_v4i16((LAS v4i16_t*)p));
}
#define MFMA16(a, b, c) __builtin_amdgcn_mfma_f32_16x16x32_bf16((a), (b), (c), 0, 0, 0)

__device__ __forceinline__ void prescan_phase(const Params& P, int l, bf16_t* QC, bf16_t* KC, int vcu, int G, const int tid) {
    const int lane = tid & 63, wave = __builtin_amdgcn_readfirstlane(tid >> 6);
    bf16_t* Z = (bf16_t*)(P.ws + WS_Z);
    const int gt = vcu * 512 + tid, NT = G * 512;
    for (int it = gt; it < (NTOK / 4) * 256; it += NT) {
        const int cc = it & 255, tgp = it >> 8, ch = cc * 8, mat = ch >> 10, rowb = 4 * tgp, pos0 = rowb & (SEQ - 1);
        const float* cw = P.conv_w + (size_t)l * 8192 + ch; const float* cb = P.conv_b + (size_t)l * 2048 + ch;
        u32x4 raw[7];
#pragma unroll
        for (int i = 0; i < 7; ++i) {
            raw[i] = (u32x4){0u, 0u, 0u, 0u};
            if (pos0 - 3 + i >= 0) raw[i] = *(const u32x4*)(Z + (size_t)(rowb - 3 + i) * ZW + ch);
        }
        f32x4 wv[4][2], bb[2];
#pragma unroll
        for (int j = 0; j < 4; ++j) { wv[j][0] = *(const f32x4*)(cw + j * 2048); wv[j][1] = *(const f32x4*)(cw + j * 2048 + 4); }
        bb[0] = *(const f32x4*)cb; bb[1] = *(const f32x4*)(cb + 4);
        bf16_t* dst = (mat ? KC : QC) + (size_t)rowb * 1024 + (ch & 1023);
        const float sc = mat ? 1.f : 0.0625f;
#pragma unroll
        for (int tt = 0; tt < 4; ++tt) {
            f32x4 o0 = bb[0], o1 = bb[1];
#pragma unroll
            for (int j = 0; j < 4; ++j) {
                const u32x4 rw = raw[tt + j];
                o0 = o0 + wv[j][0] * (f32x4){bflo(rw.x), bfhi(rw.x), bflo(rw.y), bfhi(rw.y)};
                o1 = o1 + wv[j][1] * (f32x4){bflo(rw.z), bfhi(rw.z), bflo(rw.w), bfhi(rw.w)};
            }
            o0 = o0 * sigmoid4(o0) * sc; o1 = o1 * sigmoid4(o1) * sc;
            u32x4 pk; pk.x = cvt_pk_bf16(o0[0], o0[1]); pk.y = cvt_pk_bf16(o0[2], o0[3]); pk.z = cvt_pk_bf16(o1[0], o1[1]); pk.w = cvt_pk_bf16(o1[2], o1[3]);
            *(u32x4*)(dst + (size_t)tt * 1024) = pk;
        }
    }
    const float* gates = (const float*)(P.ws + WS_GATES); f32x4* GV = (f32x4*)(P.ws + WS_GV);
    for (int task = vcu * 8 + wave; task < (NTOK / 64) * 4; task += G * 8) {
        const int h = task & 3, row = (task >> 2) * 64 + lane;
        const float li = gates[(size_t)row * 8 + h], mf = gates[(size_t)row * 8 + 4 + h];
        const float lf = fminf(mf, 0.f) - log1pf(expf(-fabsf(mf)));
        float bcs = lf;
#pragma unroll
        for (int o = 1; o < 64; o <<= 1) { const float v = __shfl_up(bcs, o); if (lane >= o) bcs += v; }
        const float a = li - bcs;
        float pm = a;
#pragma unroll
        for (int o = 1; o < 64; o <<= 1) { const float v = __shfl_up(pm, o); if (lane >= o) pm = fmaxf(pm, v); }
        GV[(size_t)row * 4 + h] = (f32x4){a, pm, bcs, 0.f};
    }
}

__device__ __forceinline__ void scan_phase(const Params& P, int l, const bf16_t* QC, const bf16_t* KC, LAS unsigned char* lds, int vcu, const int tid) {
    if (vcu >= 192) return;
    const int lane = tid & 63, wid = __builtin_amdgcn_readfirstlane(tid >> 6), r = lane & 15, q = lane >> 4;
    const bool isM = vcu < 64;
    int bh, slice; if (isM) { bh = vcu >> 2; slice = vcu & 3; } else { const int t = vcu - 64; bh = t >> 3; slice = t & 7; }
    const int b = bh >> 2, h = bh & 3;
    const int vcol = isM ? 2048 + h * 256 + slice * 64 : 5120 + h * 512 + slice * 64;
    const int hidx = isM ? h : 4 + h;
    bf16_t* Z = (bf16_t*)(P.ws + WS_Z);
    const f32x4* GV = (const f32x4*)(P.ws + WS_GV);
    float* hstat = (float*)(P.ws + WS_HSTAT);
    const bf16_t* qsrc = isM ? QC + (size_t)b * SEQ * 1024 + h * 256 : Z + (size_t)b * SEQ * ZW + 3072 + h * 256;
    const bf16_t* ksrc = isM ? KC + (size_t)b * SEQ * 1024 + h * 256 : Z + (size_t)b * SEQ * ZW + 4096 + h * 256;
    const size_t qkp = isM ? 1024 : ZW;
    LAS unsigned char* SQ = lds + S_Q; LAS unsigned char* SK = lds + S_K; LAS unsigned char* SST = lds + S_ST; LAS unsigned char* SVT = lds + S_VT;
    LAS unsigned char* SVW = lds + S_VW; LAS unsigned char* SP = lds + S_P; LAS unsigned char* OB = lds + S_Q;
    LAS float* vecU = (LAS float*)(lds + S_VEC); LAS float* vecA = vecU + 64; LAS float* vecDI = vecU + 128; LAS float* vecEN = vecU + 192;
    { unsigned zz = 0u; asm volatile("" : "+v"(zz)); const u32x4 z4 = (u32x4){zz, zz, zz, zz};
      for (int i = tid; i < (S_P - S_ST) / 16; i += 512) *(LAS u32x4*)(SST + i * 16) = z4; }
    __syncthreads();
    if (isM && tid < 64) *(LAS bf16_t*)(SVT + tid * VRP + 128) = (bf16_t)0x3F80;
    f32x4 accS[2][5];
#pragma unroll
    for (int i = 0; i < 2; ++i)
#pragma unroll
        for (int v = 0; v < 5; ++v) accS[i][v] = (f32x4){0.f, 0.f, 0.f, 0.f};
    float m_prev = 0.f;
    const float lg = logf(1.f - exp2f(-5.f - (float)h));
    const float r_u = (float)lane * lg, r_a = -(float)lane * lg, r_di = expf((float)(lane + 1) * lg), r_w = expf((float)(63 - lane) * lg), r_dec = expf(64.f * lg);
    u32x4 pq[4], pk[4], pv; f32x4 pg = (f32x4){0.f, 0.f, 0.f, 0.f};
    const int lt = tid >> 5, lc = tid & 31;
#define SCAN_ISSUE(c_) do { const size_t rb_ = (size_t)(c_) * 64; \
        _Pragma("unroll") for (int i_ = 0; i_ < 4; ++i_) { pq[i_] = *(const GASX u32x4*)(qsrc + (rb_ + lt + 16 * i_) * qkp + lc * 8); pk[i_] = *(const GASX u32x4*)(ksrc + (rb_ + lt + 16 * i_) * qkp + lc * 8); } \
        pv = *(const u32x4*)(Z + ((size_t)b * SEQ + rb_ + (tid >> 3)) * ZW + vcol + (tid & 7) * 8); \
        if (isM) pg = GV[((size_t)b * SEQ + rb_ + lane) * 4 + h]; } while (0)
    SCAN_ISSUE(0);
    __syncthreads();
#define SCAN_BAR() asm volatile("s_waitcnt lgkmcnt(0)\n\ts_barrier" ::: "memory")

    for (int c = 0; c < SEQ / 64; ++c) {
        const int row0 = b * SEQ + c * 64;
        float u_t, a_s, di, en, w, decay, m_new;
        if (isM) {
            const float a = pg[0] + pg[3], pm = pg[1], bcs = pg[2];
            const float Mt = fmaxf(m_prev, pm);
            u_t = -Mt; a_s = a; di = __expf(m_prev - Mt); en = __expf(-(bcs + Mt));
            const float Mend = __builtin_bit_cast(float, __builtin_amdgcn_readlane(__builtin_bit_cast(int, Mt), 63));
            const float bend = __builtin_bit_cast(float, __builtin_amdgcn_readlane(__builtin_bit_cast(int, bcs), 63));
            w = __expf(a - Mend); decay = __expf(m_prev - Mend); m_new = bend + Mend;
        } else { u_t = r_u; a_s = r_a; di = r_di; en = 1.f; w = r_w; decay = r_dec; m_new = 0.f; }
        if (wid == 0) { vecU[lane] = u_t; vecA[lane] = a_s; vecDI[lane] = di; vecEN[lane] = en; }
#pragma unroll
        for (int i = 0; i < 4; ++i) { *(LAS u32x4*)(SQ + (lt + 16 * i) * QP + lc * 16) = pq[i]; *(LAS u32x4*)(SK + (lt + 16 * i) * QP + lc * 16) = pk[i]; }
        {
            const int vs = tid >> 3, vch = tid & 7;
            const float ws = __shfl(w, vs);
            *(LAS u32x4*)(SVT + vs * VRP + vch * 16) = pv;
            u32x4 pw; pw.x = cvt_pk_bf16(bflo(pv.x) * ws, bfhi(pv.x) * ws); pw.y = cvt_pk_bf16(bflo(pv.y) * ws, bfhi(pv.y) * ws);
            pw.z = cvt_pk_bf16(bflo(pv.z) * ws, bfhi(pv.z) * ws); pw.w = cvt_pk_bf16(bflo(pv.w) * ws, bfhi(pv.w) * ws);
            *(LAS u32x4*)(SVW + vs * VRP + vch * 16) = pw;
            if (isM && wid == 0) *(LAS bf16_t*)(SVW + lane * VRP + 128) = (bf16_t)(cvt_pk_bf16(w, 0.f) & 0xffffu);
        }
        if (c + 1 < SEQ / 64) SCAN_ISSUE(c + 1);
        SCAN_BAR();
        {
            const int sm = wid >> 1, tn0 = (wid & 1) * 2;
            f32x4 sa[2] = {(f32x4){0.f, 0.f, 0.f, 0.f}, (f32x4){0.f, 0.f, 0.f, 0.f}};
            if (sm <= tn0 + 1) {
#pragma unroll
                for (int kb = 0; kb < 2; ++kb) {
                    bf16x8 fa[4], fb0[4], fb1[4];
#pragma unroll
                    for (int j = 0; j < 4; ++j) {
                        const int kk = kb * 4 + j;
                        fa[j] = *(const LAS bf16x8*)(SK + (sm * 16 + r) * QP + kk * 64 + q * 16);
                        fb0[j] = *(const LAS bf16x8*)(SQ + (tn0 * 16 + r) * QP + kk * 64 + q * 16);
                        fb1[j] = *(const LAS bf16x8*)(SQ + ((tn0 + 1) * 16 + r) * QP + kk * 64 + q * 16);
                    }
#pragma unroll
                    for (int j = 0; j < 4; ++j) { sa[0] = MFMA16(fa[j], fb0[j], sa[0]); sa[1] = MFMA16(fa[j], fb1[j], sa[1]); }
                }
            }
            const int s0 = sm * 16 + 4 * q;
            const f32x4 a4 = *(const LAS f32x4*)(vecA + s0);
#pragma unroll
            for (int i = 0; i < 2; ++i) {
                const int t = (tn0 + i) * 16 + r; const float ut = vecU[t];
                f32x4 pv;
#pragma unroll
                for (int j = 0; j < 4; ++j) pv[j] = (s0 + j <= t) ? sa[i][j] * __expf(ut + a4[j]) : 0.f;
                *(LAS u32x2*)(SP + t * VP + s0 * 2) = pack4(pv);
            }
        }
        SCAN_BAR();
        const int tn = wid & 3, vt0 = (wid >> 2) ? 3 : 0, nvt = (wid >> 2) ? 2 : 3;
        f32x4 oo[3];
        {
            f32x4 o1[3], o2[3];
#pragma unroll
            for (int i = 0; i < 3; ++i) { o1[i] = (f32x4){0.f, 0.f, 0.f, 0.f}; o2[i] = (f32x4){0.f, 0.f, 0.f, 0.f}; }
#pragma unroll
            for (int ks = 0; ks < 2; ++ks) {
                const bf16x8 bP = *(const LAS bf16x8*)(SP + (tn * 16 + r) * VP + ks * 64 + q * 16);
#pragma unroll
                for (int i = 0; i < 3; ++i) if (i < nvt) {
                    const LAS unsigned char* vb = SVT + (32 * ks + 8 * q + ((lane & 15) >> 2)) * VRP + (16 * (vt0 + i)) * 2 + 8 * (lane & 3);
                    const s16x4 vlo = tr_read(vb), vhi = tr_read(vb + 4 * VRP);
                    const bf16x8 aV = __builtin_shufflevector(vlo, vhi, 0, 1, 2, 3, 4, 5, 6, 7);
                    o1[i] = MFMA16(aV, bP, o1[i]);
                }
            }
#pragma unroll
            for (int kb = 0; kb < 4; ++kb) {
                bf16x8 fq[2], fs[2][3];
#pragma unroll
                for (int j = 0; j < 2; ++j) {
                    const int kk = kb * 2 + j;
                    fq[j] = *(const LAS bf16x8*)(SQ + (tn * 16 + r) * QP + kk * 64 + q * 16);
#pragma unroll
                    for (int i = 0; i < 3; ++i) if (i < nvt) fs[j][i] = *(const LAS bf16x8*)(SST + ((vt0 + i) * 16 + r) * QP + kk * 64 + q * 16);
                }
#pragma unroll
                for (int j = 0; j < 2; ++j)
#pragma unroll
                    for (int i = 0; i < 3; ++i) if (i < nvt) o2[i] = MFMA16(fs[j][i], fq[j], o2[i]);
            }
            const float dit = vecDI[tn * 16 + r];
#pragma unroll
            for (int i = 0; i < 3; ++i) oo[i] = o1[i] + o2[i] * dit;
        }
        {
#pragma unroll
            for (int i = 0; i < 2; ++i)
#pragma unroll
                for (int v = 0; v < 5; ++v) accS[i][v] = accS[i][v] * decay;
            const int qq = (lane & 15) >> 2, pp = lane & 3;
#pragma unroll
            for (int ks = 0; ks < 2; ++ks) {
                bf16x8 aK[2];
#pragma unroll
                for (int i = 0; i < 2; ++i) {
                    const LAS unsigned char* base = SK + (32 * ks + 8 * q + qq) * QP + (16 * (2 * wid + i)) * 2 + 8 * pp;
                    const s16x4 lo = tr_read(base), hi = tr_read(base + 4 * QP);
                    aK[i] = __builtin_shufflevector(lo, hi, 0, 1, 2, 3, 4, 5, 6, 7);
                }
#pragma unroll
                for (int v = 0; v < 5; ++v) {
                    const LAS unsigned char* wb = SVW + (32 * ks + 8 * q + qq) * VRP + (16 * v) * 2 + 8 * pp;
                    const s16x4 wlo = tr_read(wb), whi = tr_read(wb + 4 * VRP);
                    const bf16x8 bV = __builtin_shufflevector(wlo, whi, 0, 1, 2, 3, 4, 5, 6, 7);
                    accS[0][v] = MFMA16(aK[0], bV, accS[0][v]); accS[1][v] = MFMA16(aK[1], bV, accS[1][v]);
                }
            }
        }
        SCAN_BAR();
#pragma unroll
        for (int i = 0; i < 3; ++i) if (i < nvt) *(LAS f32x4*)(OB + (tn * 16 + r) * OBP + ((vt0 + i) * 16 + 4 * q) * 4) = oo[i];
#pragma unroll
        for (int i = 0; i < 2; ++i)
#pragma unroll
            for (int v = 0; v < 5; ++v) *(LAS u32x2*)(SST + (v * 16 + r) * QP + ((2 * wid + i) * 16 + 4 * q) * 2) = pack4(accS[i][v]);
        SCAN_BAR();
        {
            const int t = tid >> 3, vc = tid & 7;
            f32x4 n0 = *(const LAS f32x4*)(OB + t * OBP + vc * 32), n1 = *(const LAS f32x4*)(OB + t * OBP + vc * 32 + 16);
            if (isM) {
                const float den = *(const LAS float*)(OB + t * OBP + 256);
                const float inv = 1.f / fmaxf(fabsf(den), vecEN[t]);
                n0 = n0 * inv; n1 = n1 * inv;
            }
            float s = (n0[0] + n0[1]) + (n0[2] + n0[3]) + (n1[0] + n1[1]) + (n1[2] + n1[3]);
            float sq = (n0[0] * n0[0] + n0[1] * n0[1]) + (n0[2] * n0[2] + n0[3] * n0[3]) + (n1[0] * n1[0] + n1[1] * n1[1]) + (n1[2] * n1[2] + n1[3] * n1[3]);
            s += __shfl_xor(s, 1); s += __shfl_xor(s, 2); s += __shfl_xor(s, 4);
            sq += __shfl_xor(sq, 1); sq += __shfl_xor(sq, 2); sq += __shfl_xor(sq, 4);
            if (vc == 0) *(f32x2*)(hstat + ((size_t)(row0 + t) * 8 + hidx) * 16 + slice * 2) = (f32x2){s, sq};
            u32x4 pk; pk.x = cvt_pk_bf16(n0[0], n0[1]); pk.y = cvt_pk_bf16(n0[2], n0[3]); pk.z = cvt_pk_bf16(n1[0], n1[1]); pk.w = cvt_pk_bf16(n1[2], n1[3]);
            *(u32x4*)(Z + (size_t)(row0 + t) * ZW + vcol + vc * 8) = pk;
        }
        m_prev = m_new;
        SCAN_BAR();
    }
}


#define XB_TMO      128
#define XB_XCNT(j)  (256  + 64 * (j))
#define XB_XSUB(j)  (1280 + 64 * (j))
#define XB_XGEN(j)  (2304 + 64 * (j))
#define XB_TOP      3328
#define XB_TOPGEN   3392
#define XCD_BAR_WORDS 3456
#define XB_SPIN_CAP (1u << 18)
__device__ __forceinline__ unsigned xb_ld(unsigned* p)              { return __hip_atomic_load(p, __ATOMIC_RELAXED, __HIP_MEMORY_SCOPE_AGENT); }
__device__ __forceinline__ unsigned xb_add(unsigned* p, unsigned v) { return __hip_atomic_fetch_add(p, v, __ATOMIC_RELAXED, __HIP_MEMORY_SCOPE_AGENT); }
__device__ __forceinline__ unsigned xb_xcc_id() { return (unsigned)__builtin_amdgcn_s_getreg((3 << 11) | 20) & 0xFu; }
#define XB_SPIN(cond, bar) do { unsigned _sp = 0; while (cond) { __builtin_amdgcn_s_sleep(1); \
    if ((++_sp & 255u) == 0u) { if (xb_ld(&(bar)[XB_TMO])) break; if (_sp > XB_SPIN_CAP) { atomicAdd(&(bar)[XB_TMO], 1u); break; } } } } while (0)
struct XcdBarrier { unsigned* bar; unsigned x; volatile LAS unsigned* st; };
__device__ __forceinline__ XcdBarrier xcd_barrier_post(unsigned* bar, volatile LAS unsigned* st, const bool t0) {
    XcdBarrier b; b.bar = bar; b.x = xb_xcc_id(); b.st = st;
    if (t0) (void)xb_add(&bar[XB_XCNT(b.x)], 1u);
    return b;
}
__device__ __forceinline__ void xcd_barrier_complete(unsigned* bar, unsigned x, unsigned& nloc, unsigned& nx) {
    const unsigned G = gridDim.x * gridDim.y * gridDim.z;
    unsigned sum, cnt, mine, sp = 0u;
    for (;;) {
        sum = 0u; cnt = 0u; mine = 0u;
#pragma unroll
        for (unsigned j = 0; j < 16; ++j) { const unsigned c = xb_ld(&bar[XB_XCNT(j)]); sum += c; cnt += (c > 0u) ? 1u : 0u; mine = (j == x) ? c : mine; }
        if (sum == G) break;
        __builtin_amdgcn_s_sleep(1);
        if ((++sp & 255u) == 0u) { if (xb_ld(&bar[XB_TMO])) break; if (sp > XB_SPIN_CAP) { atomicAdd(&bar[XB_TMO], 1u); break; } }
    }
    nloc = mine > 0u ? mine : 1u; nx = cnt > 0u ? cnt : 1u;
}
__device__ __forceinline__ void xcd_barrier(const XcdBarrier& b, const bool t0) {
    asm volatile("s_waitcnt vmcnt(0)" ::: "memory");
    __syncthreads();
    if (t0) {
        unsigned* bar = b.bar;
        __builtin_amdgcn_s_waitcnt(0);
        unsigned nloc = b.st[0], nx = b.st[1];
        if (nloc == 0u) { xcd_barrier_complete(bar, b.x, nloc, nx); b.st[0] = nloc; b.st[1] = nx; }
        const unsigned old = xb_add(&bar[XB_XSUB(b.x)], 1u);
        const unsigned gen = old / nloc;
        if (old + 1u == (gen + 1u) * nloc) {
            __builtin_amdgcn_fence(__ATOMIC_RELEASE, "agent");
            asm volatile("s_waitcnt vmcnt(0)" ::: "memory");
            const unsigned og = xb_add(&bar[XB_TOP], 1u);
            const unsigned tg = og / nx;
            if (og + 1u == (tg + 1u) * nx) xb_add(&bar[XB_TOPGEN], 1u);
            else XB_SPIN(xb_ld(&bar[XB_TOPGEN]) == tg, bar);
            __builtin_amdgcn_fence(__ATOMIC_ACQUIRE, "agent");
            xb_add(&bar[XB_XGEN(b.x)], 1u);
            asm volatile("s_waitcnt vmcnt(0)" ::: "memory");
        } else {
            XB_SPIN(xb_ld(&bar[XB_XGEN(b.x)]) == gen, bar);
            __builtin_amdgcn_fence(__ATOMIC_ACQUIRE, "agent");
            asm volatile("s_waitcnt vmcnt(0)" ::: "memory");
        }
    }
    __syncthreads();
}

#ifndef PHMASK
#define PHMASK 0xFFFF
#endif
#define PH(n) ((PHMASK >> (n)) & 1)
#define LQ() int lq = l; unsigned char* ws = P.ws; asm volatile("" : "+s"(lq)); asm volatile("" : "+s"(ws)); \
    bf16_t* Z = (bf16_t*)(ws + WS_Z); bf16_t* MG = (bf16_t*)(ws + WS_MG); float* gates = (float*)(ws + WS_GATES); float* hstat = (float*)(ws + WS_HSTAT); \
    bf16_t* XBc = (bf16_t*)(ws + ((lq & 1) ? WS_XB1 : WS_XB0)); bf16_t* XBn = (bf16_t*)(ws + ((lq & 1) ? WS_XB0 : WS_XB1)); \
    float* ssc = (float*)(ws + ((lq & 1) ? WS_SS1 : WS_SS0)); float* ssn = (float*)(ws + ((lq & 1) ? WS_SS0 : WS_SS1)); \
    const float* bin = P.b_in + (size_t)lq * NIN; \
    bf16_t* WYc = (bf16_t*)(ws + ((lq & 1) ? WS_WY1 : WS_WY)); bf16_t* WYn = (bf16_t*)(ws + ((lq & 1) ? WS_WY : WS_WY1)); \
    bf16_t* WGMc = (bf16_t*)(ws + ((lq & 1) ? WS_WGM1 : WS_WGM)); bf16_t* WGMn = (bf16_t*)(ws + ((lq & 1) ? WS_WGM : WS_WGM1)); \
    bf16_t* WGRc = (bf16_t*)(ws + ((lq & 1) ? WS_WGR1 : WS_WGR)); bf16_t* WGRn = (bf16_t*)(ws + ((lq & 1) ? WS_WGR : WS_WGR1)); \
    (void)Z; (void)MG; (void)gates; (void)hstat; (void)XBc; (void)XBn; (void)ssc; (void)ssn; (void)bin; (void)WYc; (void)WYn; (void)WGMc; (void)WGMn; (void)WGRc; (void)WGRn
#define OPQ() int tq = wave * 64 + lane_id_fresh(), vcuq = vcu, Gq = G; asm volatile("" : "+s"(vcuq), "+s"(Gq))
__global__ void __launch_bounds__(512, 2) fwd_megakernel(Params P) {
    extern __shared__ __attribute__((aligned(16))) unsigned char lds_raw[];
    LAS unsigned char* lds = (LAS unsigned char*)lds_raw;
    cg::grid_group grid = cg::this_grid();
    const int G = gridDim.x, bx = blockIdx.x;
    const int vcu = (G % 8 == 0) ? (bx % 8) * (G / 8) + bx / 8 : bx;
    const int wave = __builtin_amdgcn_readfirstlane((int)threadIdx.x >> 6);
    unsigned* barw = (unsigned*)(P.ws + WS_CTL);
    volatile LAS unsigned* bst = (volatile LAS unsigned*)(lds + LDS_BYTES - 64);
    { const int tid0 = threadIdx.x; if (bx == 0) for (int i = tid0; i < XCD_BAR_WORDS; i += 512) barw[i] = 0u;
      if (tid0 < 2) bst[tid0] = 0u; }
    XcdBarrier xbar; xbar.bar = barw; xbar.x = 0; xbar.st = bst;
    bool posted = false;
#define LANEID() ((int)__builtin_amdgcn_mbcnt_hi(~0u, __builtin_amdgcn_mbcnt_lo(~0u, 0u)))
#define GSYNC() do { const bool t0_ = (wave == 0) && (lane_id_fresh() == 0); if (!posted) { grid.sync(); xbar = xcd_barrier_post(barw, bst, t0_); posted = true; } else xcd_barrier(xbar, t0_); } while (0)
    { OPQ(); prep0_phase(P, vcuq, Gq, tq); }
    for (int l = 0; l < NLAYER; ++l) {
        if (l == 0) { { LQ(); OPQ(); prep_phase(P, 0, 0, WYc, WGMc, WGRc, lds, vcuq * 8, Gq * 8, tq); } GSYNC(); }
        if (PH(1)) {
            LQ();
            Sched<1> S; S.T.init(NTOK, 7424, G, bx);
            S.g0 = SubG{(const char*)XBc, (const char*)(ws + WS_W1), 2048u, 2048u, 16}; S.g1 = S.g0; S.g2 = S.g0; S.g3 = S.g0;
            EpiIn E{ssc, bin, Z, gates, (const float*)(ws + WS_ROPE)};
            { OPQ(); gemm_phase(lds, S, E, tq); }
        }
        GSYNC();
        if (PH(2)) { LQ(); OPQ(); prescan_phase(P, lq, MG, XBn, vcuq, Gq, tq); pconv_phase(P, lq, vcuq * 8, Gq * 8, tq); }
        GSYNC();
        if (PH(2)) { LQ(); OPQ(); scan_phase(P, lq, MG, XBn, lds, vcuq, tq); }
        if (vcu >= 192) {   LQ();
            { OPQ(); prep_phase(P, lq, 1, WYn, WGMn, WGRn, lds, (vcuq - 192) * 8, 512, tq); }
            if (lq + 1 < NLAYER) { OPQ(); prep_phase(P, lq + 1, 0, WYn, WGMn, WGRn, lds, (vcuq - 192) * 8, 512, tq); }
            __syncthreads();
            Sched<1> S; S.T.init(NTOK, 1024, 64, vcu - 192);
            S.g0 = SubG{(const char*)XBc, (const char*)WGMc, 2048u, 2048u, 16}; S.g1 = S.g0; S.g2 = S.g0; S.g3 = S.g0;
            EpiMerge E{ssc, bin, Z, MG, 0};
            { OPQ(); gemm_phase(lds, S, E, tq); }
        }
        GSYNC();
        if (PH(3)) {
            LQ();
            Sched<1> S; S.T.init(NTOK, 3072, G, bx);
            S.g0 = SubG{(const char*)XBc, (const char*)WYc, 2048u, 2048u, 16}; S.g1 = S.g0; S.g2 = S.g0; S.g3 = S.g0;
            EpiY E{ssc, bin, Z, hstat, P.m_norm_g + lq * 1024, P.r_norm_g + lq * 2048};
            { OPQ(); gemm_phase(lds, S, E, tq); }
        }
        GSYNC();
        if (PH(4)) {
            LQ();
            Sched<3> S; S.T.init(NTOK, 1024, G, bx);
            S.g0 = SubG{(const char*)(Z + 2048), (const char*)(ws + WS_WBM), (unsigned)(ZW * 2), 2048u, 16};
            S.g1 = SubG{(const char*)XBc, (const char*)WGRc, 2048u, 2048u, 16};
            S.g2 = SubG{(const char*)(Z + 5120), (const char*)(ws + WS_WBR), (unsigned)(ZW * 2), 4096u, 32};
            S.g3 = S.g0;
            EpiMerge E{ssc, bin, Z, MG, 1};
            { OPQ(); gemm_phase(lds, S, E, tq); }
        }
        GSYNC();
        if (PH(5)) {
            LQ();
            Sched<1> S; S.T.init(NTOK, 1024, G, bx);
            S.g0 = SubG{(const char*)MG, (const char*)(ws + WS_WOUT), 2048u, 2048u, 16}; S.g1 = S.g0; S.g2 = S.g0; S.g3 = S.g0;
            EpiX E{XBc, XBc, ssc, nullptr};
            { OPQ(); gemm_phase(lds, S, E, tq); }
        }
        GSYNC();
        if (PH(6)) {
            LQ();
            Sched<1> S; S.T.init(NTOK, FF, G, bx);
            S.g0 = SubG{(const char*)XBc, (const char*)(ws + WS_WFF1), 2048u, 2048u, 16}; S.g1 = S.g0; S.g2 = S.g0; S.g3 = S.g0;
            EpiFF1 E{ssc, P.b_ff1 + (size_t)lq * FF, Z};
            { OPQ(); gemm_phase(lds, S, E, tq); }
        }
        GSYNC();
        if (PH(7)) {
            LQ();
            Sched<1> S; S.T.init(NTOK, 1024, G, bx);
            S.g0 = SubG{(const char*)Z, (const char*)(ws + WS_WFF2), 8192u, 8192u, 64}; S.g1 = S.g0; S.g2 = S.g0; S.g3 = S.g0;
            EpiX E{XBc, XBc, ssc, P.b_ff2 + (size_t)lq * DM};
            { OPQ(); gemm_phase(lds, S, E, tq); }
        }
        GSYNC();
        if (PH(8)) {
            LQ();
            Sched<2> S; S.T.init(NTOK, 1024, G, bx);
            S.g0 = SubG{(const char*)XBc, (const char*)(ws + WS_WPG), 2048u, 2048u, 16};
            S.g1 = SubG{(const char*)(ws + WS_PB), (const char*)(ws + WS_WPE), 512u, 512u, 4};
            S.g2 = S.g0; S.g3 = S.g0;
            EpiPE E{ssc, Z, XBc, XBn, ssn};
            { OPQ(); gemm_phase(lds, S, E, tq); }
        }
        GSYNC();
    }
    {
        unsigned char* ws = P.ws;
        const float* ss = (const float*)(ws + WS_SS0);
        const bf16_t* XBf = (const bf16_t*)(ws + WS_XB0);
        const int lane = lane_id_fresh();
        const int gw = vcu * 8 + wave, NGW = G * 8;
        for (int row = gw; row < NTOK; row += NGW) {
            float s = (lane < 16) ? ss[(size_t)row * 16 + lane] : 0.f;
#pragma unroll
            for (int o = 1; o < 64; o <<= 1) s += __shfl_xor(s, o);
            const float rs = rsqrtf(s * (1.f / DM) + EPS);
#pragma unroll
            for (int j = 0; j < 2; ++j) {
                const u32x4 w = *((const u32x4*)(XBf + (size_t)row * DM) + lane + 64 * j);
                f32x4 x0, x1; unpack8(w, x0, x1);
                const f32x4 g0 = *((const f32x4*)P.final_g + 2 * (lane + 64 * j)), g1 = *((const f32x4*)P.final_g + 2 * (lane + 64 * j) + 1);
                f32x4* o = (f32x4*)(P.out + (size_t)row * DM) + 2 * (lane + 64 * j);
                o[0] = x0 * rs * g0; o[1] = x1 * rs * g1;
            }
        }
    }
}

extern "C" void kernel_launch(void* const* d_in, const int* in_sizes, int n_in, void* d_out, int out_size, void* d_ws, size_t ws_size, hipStream_t stream) {
    static int grid = 0;
    if (grid == 0) {
        if (n_in != 21 || out_size != NTOK * DM || ws_size < WS_END) { fprintf(stderr, "kernel_launch: unexpected shapes / workspace (n_in %d out %d ws %zu)\n", n_in, out_size, ws_size); grid = -1; return; }
        int dev = 0, cus = 0, per_cu = 0;
        (void)hipGetDevice(&dev);
        (void)hipDeviceGetAttribute(&cus, hipDeviceAttributeMultiprocessorCount, dev);
        (void)hipFuncSetAttribute((const void*)fwd_megakernel, hipFuncAttributeMaxDynamicSharedMemorySize, LDS_BYTES);
        (void)hipOccupancyMaxActiveBlocksPerMultiprocessor(&per_cu, (const void*)fwd_megakernel, 512, LDS_BYTES);
        (void)hipGetLastError();
        if (per_cu < 1) per_cu = 1;
        grid = cus;
    }
    if (grid < 0) return;
    Params p{};
    const float** pp = (const float**)&p;
    for (int i = 0; i < 21; ++i) pp[i] = (const float*)d_in[i];
    p.out = (float*)d_out; p.ws = (unsigned char*)d_ws;
    void* args[] = {&p};
    hipError_t e = hipLaunchCooperativeKernel((const void*)fwd_megakernel, dim3(grid), dim3(512), args, LDS_BYTES, stream);
    if (e != hipSuccess) fprintf(stderr, "cooperative launch failed: %s (grid %d)\n", hipGetErrorString(e), grid);
}
```
